# Optimizing an MI355X kernel written in HIP

```python
import jax, jax.numpy as jnp
from jax import lax
import numpy as np

D_MODEL = 1024
BATCH = 16
SEQ = 2048
DEPTH = 4

N_META = 16
POOL_WINDOWS = (2, 4, 8, 16)
N_POOL_GROUPS = len(POOL_WINDOWS)
POOL_GROUP_DIM = D_MODEL // N_POOL_GROUPS
CONV_WIDTH = 3
D_FF = 2816
N_MIXERS = 2
N_POOL_LAYERS = (DEPTH + 1) // 2
N_CONV_LAYERS = DEPTH // 2
RMS_EPS = 1e-6

kernel_name = "hybrid_pool_shortconv_convffn_trunk"


def rms_norm(x, g):
    xf = x.astype(jnp.float32)
    y = xf * lax.rsqrt(jnp.mean(xf * xf, axis=-1, keepdims=True) + RMS_EPS)
    return (y * g.astype(jnp.float32)).astype(x.dtype)


def causal_dwconv3(x, w):
    L = x.shape[1]
    xp = jnp.pad(x, ((0, 0), (CONV_WIDTH - 1, 0), (0, 0)))
    return w[0] * xp[:, 0:L] + w[1] * xp[:, 1:L + 1] + w[2] * xp[:, 2:L + 2]


def pool_mixer(h, w_group, scale):
    Bsz, L, _ = h.shape
    hf = h.astype(jnp.float32).reshape(Bsz, L, N_POOL_GROUPS, POOL_GROUP_DIM)
    csum = jnp.cumsum(hf, axis=1)
    pos = jnp.arange(L, dtype=jnp.float32)
    outs = []
    for g, w in enumerate(POOL_WINDOWS):
        cg = csum[:, :, g]
        prev = jnp.pad(cg, ((0, 0), (w, 0), (0, 0)))[:, :L]
        count = jnp.minimum(pos + 1.0, float(w))[None, :, None]
        outs.append((cg - prev) / count - hf[:, :, g])
    pooled = jnp.stack(outs, axis=2).astype(h.dtype)
    y = jnp.einsum('blgc,gcd->blgd', pooled, w_group).reshape(Bsz, L, D_MODEL)
    return y * scale


def short_conv_mixer(h, w_in, conv_w, w_out):
    bcv = jnp.einsum('bld,de->ble', h, w_in)
    b_gate, c_gate, v = jnp.split(bcv, 3, axis=-1)
    y = b_gate * causal_dwconv3(c_gate * v, conv_w)
    return jnp.einsum('bld,de->ble', y, w_out)


def conv_ffn(h, w_up, conv_w, w_down):
    up = jnp.einsum('bld,df->blf', h, w_up)
    gate, val = jnp.split(up, 2, axis=-1)
    gate = causal_dwconv3(gate, conv_w)
    return jnp.einsum('blf,fd->bld', jax.nn.silu(gate) * val, w_down)


def setup_inputs(seed: int = 0) -> dict:
    key = jax.random.key(seed)
    ks = jax.random.split(key, 12)
    f32 = jnp.float32
    D = D_MODEL
    x = jax.random.normal(ks[0], (BATCH, SEQ, D), f32)
    meta_tokens = jax.random.normal(ks[1], (N_META, D), f32)
    pool_w = jax.random.normal(ks[2], (N_POOL_LAYERS, N_POOL_GROUPS, POOL_GROUP_DIM, POOL_GROUP_DIM), f32) * POOL_GROUP_DIM ** -0.5
    pool_scale = 1.0 + 0.1 * jax.random.normal(ks[3], (N_POOL_LAYERS, D), f32)
    sc_w_in = jax.random.normal(ks[4], (N_CONV_LAYERS, D, 3 * D), f32) * D ** -0.5
    sc_conv = jax.random.normal(ks[5], (N_CONV_LAYERS, CONV_WIDTH, D), f32) * CONV_WIDTH ** -0.5
    sc_w_out = jax.random.normal(ks[6], (N_CONV_LAYERS, D, D), f32) * D ** -0.5
    ffn_w_up = jax.random.normal(ks[7], (DEPTH, D, 2 * D_FF), f32) * D ** -0.5
    ffn_conv = jax.random.normal(ks[8], (DEPTH, CONV_WIDTH, D_FF), f32) * CONV_WIDTH ** -0.5
    ffn_w_down = jax.random.normal(ks[9], (DEPTH, D_FF, D), f32) * D_FF ** -0.5
    norm_g = 1.0 + 0.05 * jax.random.normal(ks[10], (DEPTH, 4, D), f32)
    return {"x": x, "meta_tokens": meta_tokens, "pool_w": pool_w, "pool_scale": pool_scale,
            "sc_w_in": sc_w_in, "sc_conv": sc_conv, "sc_w_out": sc_w_out,
            "ffn_w_up": ffn_w_up, "ffn_conv": ffn_conv, "ffn_w_down": ffn_w_down,
            "norm_g": norm_g}


def reference(x, meta_tokens, pool_w, pool_scale, sc_w_in, sc_conv, sc_w_out,
              ffn_w_up, ffn_conv, ffn_w_down, norm_g):
    Bsz = x.shape[0]
    meta = jnp.broadcast_to(meta_tokens.astype(x.dtype)[None], (Bsz, N_META, D_MODEL))
    h = jnp.concatenate([meta, x], axis=1)
    for i in range(DEPTH):
        j = i // N_MIXERS
        u = rms_norm(h, norm_g[i, 0])
        if i % N_MIXERS == 0:
            m = pool_mixer(u, pool_w[j], pool_scale[j])
        else:
            m = short_conv_mixer(u, sc_w_in[j], sc_conv[j], sc_w_out[j])
        h = h + rms_norm(m, norm_g[i, 1])
        u = rms_norm(h, norm_g[i, 2])
        f = conv_ffn(u, ffn_w_up[i], ffn_conv[i], ffn_w_down[i])
        h = h + rms_norm(f, norm_g[i, 3])
    return h[:, N_META:]
```

```cpp
#include <hip/hip_runtime.h>
#include <hip/hip_cooperative_groups.h>
#include <cstdio>
namespace cg = cooperative_groups;

#ifndef MK_ONE_LAUNCH
#define MK_ONE_LAUNCH 0
#endif

#define LAS __attribute__((address_space(3)))
typedef unsigned short bf16_t;
typedef short bf16x8 __attribute__((ext_vector_type(8)));
typedef float f32x4 __attribute__((ext_vector_type(4)));
typedef unsigned u32x4 __attribute__((ext_vector_type(4)));
typedef unsigned u32x2 __attribute__((ext_vector_type(2)));

constexpr int DM = 1024, FF = 2816, SEQ = 2048, NB = 16, NMETA = 16;
constexpr int MREAL = NB * SEQ;
constexpr int MROWS = MREAL + 256;
constexpr int NTM = MROWS / 256;
constexpr int META_TILE = MREAL / 256;
constexpr float RMS_EPS = 1e-6f;

constexpr int BM = 256, BK = 64, HALF = 128, HTB = HALF * BK * 2, STAGE_BYTES = 8 * HTB, NXCD = 8, WGM = 8;
constexpr int XCH_BYTES = 4 * 2 * 128 * 4;
constexpr int LDS_BYTES = STAGE_BYTES + XCH_BYTES;

constexpr size_t al256(size_t x) { return (x + 255) & ~(size_t)255; }
constexpr size_t WS_HB    = 0;
constexpr size_t WS_F     = WS_HB + al256((size_t)MROWS * DM * 2);
constexpr size_t WS_ACT   = WS_F + al256((size_t)MROWS * DM * 2);
constexpr size_t WS_WUP   = WS_ACT + al256((size_t)MROWS * 3072 * 2);
constexpr size_t WS_WDN   = WS_WUP + al256((size_t)4 * 5632 * 1024 * 2);
constexpr size_t WS_WIN   = WS_WDN + al256((size_t)4 * 1024 * 2816 * 2);
constexpr size_t WS_WOUT  = WS_WIN + al256((size_t)2 * 3072 * 1024 * 2);
constexpr size_t WS_WP    = WS_WOUT + al256((size_t)2 * 1024 * 1024 * 2);
constexpr size_t WS_HMETA = WS_WP + al256((size_t)2 * 1024 * 256 * 2);
constexpr size_t WS_RSTD  = WS_HMETA + al256((size_t)256 * DM * 4);
constexpr size_t WS_SSF   = WS_RSTD + al256((size_t)MROWS * 4);
constexpr size_t WS_HG    = WS_SSF + al256((size_t)MROWS * 16 * 4);
constexpr size_t WS_HR    = WS_HG + al256((size_t)NTM * 2 * FF * 4);
constexpr size_t WS_ONES  = WS_HR + al256((size_t)NTM * 4 * FF * 4);
constexpr size_t WS_END   = WS_ONES + al256((size_t)DM * 4);

struct Params {
    const float* x; const float* meta; const float* pool_w; const float* pool_scale; const float* sc_w_in; const float* sc_conv; const float* sc_w_out;
    const float* ffn_w_up; const float* ffn_conv; const float* ffn_w_down; const float* norm_g;
    float* out; unsigned char* ws; int ph_lo, ph_hi, coop, pad;
};

__device__ __forceinline__ unsigned cvt_pk_bf16(float lo, float hi) { unsigned r; asm("v_cvt_pk_bf16_f32 %0, %1, %2" : "=v"(r) : "v"(lo), "v"(hi)); return r; }
__device__ __forceinline__ float bf_lo(unsigned w) { return __uint_as_float(w << 16); }
__device__ __forceinline__ float bf_hi(unsigned w) { return __uint_as_float(w & 0xffff0000u); }
__device__ __forceinline__ float wave_sum(float v) {
#pragma unroll
    for (int o = 32; o >= 1; o >>= 1) v += __shfl_xor(v, o);
    return v;
}
__device__ __forceinline__ int prev_row(int row, int k) {
    if (row < MREAL) { const int t = row & (SEQ - 1); return (t >= k) ? row - k : MREAL + NMETA + t - k; }
    const int m = row - MREAL; return (m >= k) ? row - k : -1;
}
__device__ __forceinline__ float* hrow(const Params& p, int row) { return row < MREAL ? p.out + (size_t)row * DM : (float*)(p.ws + WS_HMETA) + (size_t)(row - MREAL) * DM; }
__device__ __forceinline__ float silu_mul(float c, float v) { return c * __builtin_amdgcn_rcpf(1.0f + __builtin_amdgcn_exp2f(-1.44269504089f * c)) * v; }

__device__ __forceinline__ int lds_byte(int r, int c) { const int st = (r >> 4) * 2 + (c >> 5), rr = r & 15, cc = c & 31, ob = rr * 64 + cc * 2; return st * 1024 + (ob ^ (((ob >> 9) & 1) << 5)); }
__device__ __forceinline__ void stage_rc(int b, int& R, int& C) { const int st = b / 1024, sb = b % 1024, swz = sb ^ (((sb >> 9) & 1) << 5); R = (st >> 1) * 16 + swz / 64; C = (st & 1) * 32 + (swz % 64) / 2; }
__device__ __forceinline__ int perm32(int rho) { const int n = rho >> 4, i = rho & 15; return 8 * (i >> 2) + 4 * n + (i & 3); }

struct Ctx { int tid, bid, nblk; };
struct Unit { int pm, pn; };
struct Gemm { const bf16_t* A; const bf16_t* Bt; int M, N, K, lda, ldb, a_pn_bytes; };

struct StaticOrder {
    int nM, nN, nwg, G, c;
    __device__ void init(int M, int N, int G_, int c_) { nM = M / BM; nN = N / BM; nwg = nM * nN; G = G_; c = c_; }
    __device__ bool next(int i, Unit& u) const {
        const long L = (long)i * G + c; if (L >= nwg) return false;
        int wgid = (int)L; { const int q = nwg / NXCD, r = nwg % NXCD, xcd = wgid % NXCD, off = wgid / NXCD; wgid = (xcd < r ? xcd * (q + 1) : r * (q + 1) + (xcd - r) * q) + off; }
        const int nig = WGM * nN, gid = wgid / nig, fm = gid * WGM, gsz = (nM - fm) < WGM ? (nM - fm) : WGM;
        u.pm = fm + ((wgid % nig) % gsz); u.pn = (wgid % nig) / gsz; return true;
    }
};

struct EpiF {
    bf16_t* F; float* ssp; const float* scale;
    __device__ __forceinline__ void operator()(f32x4 (&acc)[2][2][4][2], const Unit& u, int wr, int wc, int fr, int fq, LAS unsigned char*) const {
        asm volatile("" : "+v"(fr), "+v"(fq), "+s"(wr), "+s"(wc));
        const int row0 = u.pm * BM + wr * 64 + fr, col0 = u.pn * BM + wc * 32 + 8 * fq;
        f32x4 sc[2][2];
#pragma unroll
        for (int bj = 0; bj < 2; ++bj)
#pragma unroll
            for (int n = 0; n < 2; ++n) sc[bj][n] = *(const f32x4*)(scale + col0 + bj * HALF + 4 * n);
#pragma unroll
        for (int ai = 0; ai < 2; ++ai)
#pragma unroll
            for (int m = 0; m < 4; ++m) {
                const int row = row0 + ai * HALF + m * 16; float s = 0.f;
#pragma unroll
                for (int bj = 0; bj < 2; ++bj) {
                    const f32x4 v0 = acc[ai][bj][m][0] * sc[bj][0], v1 = acc[ai][bj][m][1] * sc[bj][1];
                    s += (v0[0] * v0[0] + v0[1] * v0[1]) + (v0[2] * v0[2] + v0[3] * v0[3]) + (v1[0] * v1[0] + v1[1] * v1[1]) + (v1[2] * v1[2] + v1[3] * v1[3]);
                    u32x4 w; w.x = cvt_pk_bf16(v0[0], v0[1]); w.y = cvt_pk_bf16(v0[2], v0[3]); w.z = cvt_pk_bf16(v1[0], v1[1]); w.w = cvt_pk_bf16(v1[2], v1[3]);
                    *(u32x4*)(F + (size_t)row * DM + col0 + bj * HALF) = w;
                }
                s += __shfl_xor(s, 16); s += __shfl_xor(s, 32);
                if (fq == 0) ssp[(size_t)row * 16 + u.pn * 4 + wc] = s;
            }
    }
};
struct EpiIn {
    bf16_t* CV; bf16_t* Bb; const float* rstd;
    __device__ __forceinline__ void operator()(f32x4 (&acc)[2][2][4][2], const Unit& u, int wr, int wc, int fr, int fq, LAS unsigned char*) const {
        asm volatile("" : "+v"(fr), "+v"(fq), "+s"(wr), "+s"(wc));
        const int row0 = u.pm * BM + wr * 64 + fr;
        if (u.pn < 8) {
            const int col0 = u.pn * HALF + wc * 32 + 8 * fq;
#pragma unroll
            for (int ai = 0; ai < 2; ++ai)
#pragma unroll
                for (int m = 0; m < 4; ++m) {
                    const int row = row0 + ai * HALF + m * 16; const float r = rstd[row], r2 = r * r;
                    const f32x4 v0 = acc[ai][0][m][0] * acc[ai][1][m][0] * r2, v1 = acc[ai][0][m][1] * acc[ai][1][m][1] * r2;
                    u32x4 w; w.x = cvt_pk_bf16(v0[0], v0[1]); w.y = cvt_pk_bf16(v0[2], v0[3]); w.z = cvt_pk_bf16(v1[0], v1[1]); w.w = cvt_pk_bf16(v1[2], v1[3]);
                    *(u32x4*)(CV + (size_t)row * DM + col0) = w;
                }
        } else {
            const int col0 = (u.pn - 8) * BM + wc * 32 + 8 * fq;
#pragma unroll
            for (int ai = 0; ai < 2; ++ai)
#pragma unroll
                for (int m = 0; m < 4; ++m) {
                    const int row = row0 + ai * HALF + m * 16; const float r = rstd[row];
#pragma unroll
                    for (int bj = 0; bj < 2; ++bj) {
                        const f32x4 v0 = acc[ai][bj][m][0] * r, v1 = acc[ai][bj][m][1] * r;
                        u32x4 w; w.x = cvt_pk_bf16(v0[0], v0[1]); w.y = cvt_pk_bf16(v0[2], v0[3]); w.z = cvt_pk_bf16(v1[0], v1[1]); w.w = cvt_pk_bf16(v1[2], v1[3]);
                        *(u32x4*)(Bb + (size_t)row * DM + col0 + bj * HALF) = w;
                    }
                }
        }
    }
};
struct EpiUp {
    bf16_t* A; const float* rstd; const float* cw; float* hg; float* hr;
    __device__ __forceinline__ void operator()(f32x4 (&acc)[2][2][4][2], const Unit& u, int wr, int wc, int fr, int fq, LAS unsigned char* lds) const {
        asm volatile("" : "+v"(fr), "+v"(fq), "+s"(wr), "+s"(wc));
        LAS float* X = (LAS float*)(lds + STAGE_BYTES);
        const int lane = fq * 16 + fr;
        const int jl = wc * 32 + 8 * fq, j0 = u.pn * HALF + jl, rowt = wr * 64 + fr;
#pragma unroll
        for (int ai = 0; ai < 2; ++ai)
#pragma unroll
            for (int m = 0; m < 4; ++m) {
                const float r = rstd[u.pm * BM + ai * HALF + m * 16 + rowt];
#pragma unroll
                for (int bj = 0; bj < 2; ++bj)
#pragma unroll
                    for (int n = 0; n < 2; ++n) acc[ai][bj][m][n] *= r;
            }
        const bool meta = (u.pm == META_TILE);
        if (fr >= 14) {
#pragma unroll
            for (int ai = 0; ai < 2; ++ai)
#pragma unroll
                for (int n = 0; n < 2; ++n) *(LAS f32x4*)(X + ((2 * ai + wr) * 2 + (fr - 14)) * 128 + jl + 4 * n) = acc[ai][0][3][n];
            if (meta) { if (wr == 0) {
#pragma unroll
                for (int n = 0; n < 2; ++n) *(f32x4*)(hg + ((size_t)u.pm * 2 + (fr - 14)) * FF + j0 + 4 * n) = acc[0][0][0][n]; }
            } else if (wr == 1) {
#pragma unroll
                for (int n = 0; n < 2; ++n) *(f32x4*)(hg + ((size_t)u.pm * 2 + (fr - 14)) * FF + j0 + 4 * n) = acc[1][0][3][n];
            }
        }
        if (fr < 2 && wr == 0) {
#pragma unroll
            for (int n = 0; n < 2; ++n) {
                *(f32x4*)(hr + (((size_t)u.pm * 2 + fr) * 2 + 0) * FF + j0 + 4 * n) = acc[0][0][0][n];
                *(f32x4*)(hr + (((size_t)u.pm * 2 + fr) * 2 + 1) * FF + j0 + 4 * n) = acc[0][1][0][n];
            }
        }
        asm volatile("s_waitcnt lgkmcnt(0)" ::: "memory"); __builtin_amdgcn_s_barrier(); __builtin_amdgcn_s_barrier(); asm volatile("" ::: "memory");
        f32x4 w0[2], w1[2], w2[2];
#pragma unroll
        for (int n = 0; n < 2; ++n) { w0[n] = *(const f32x4*)(cw + j0 + 4 * n); w1[n] = *(const f32x4*)(cw + FF + j0 + 4 * n); w2[n] = *(const f32x4*)(cw + 2 * FF + j0 + 4 * n); }
        const int src1 = (lane & 48) | ((fr + 15) & 15), src2 = (lane & 48) | ((fr + 14) & 15);
#pragma unroll
        for (int ai = 0; ai < 2; ++ai) {
            const int q = 2 * ai + wr;
            f32x4 gp[2];
#pragma unroll
            for (int n = 0; n < 2; ++n) { gp[n] = (f32x4){0.f, 0.f, 0.f, 0.f}; if (q > 0 && fr >= 14) gp[n] = *(LAS f32x4*)(X + ((q - 1) * 2 + (fr - 14)) * 128 + jl + 4 * n); }
#pragma unroll
            for (int m = 0; m < 4; ++m) {
                const int row = u.pm * BM + ai * HALF + m * 16 + rowt;
                u32x4 pk;
#pragma unroll
                for (int n = 0; n < 2; ++n) {
                    const f32x4 G = acc[ai][0][m][n], Gp = (m == 0) ? gp[n] : acc[ai][0][m == 0 ? 0 : m - 1][n], V = acc[ai][1][m][n];
                    f32x4 o;
#pragma unroll
                    for (int e = 0; e < 4; ++e) {
                        const float s1 = (fr == 15) ? Gp[e] : G[e], s2 = (fr >= 14) ? Gp[e] : G[e];
                        const float p1 = __shfl(s1, src1), p2 = __shfl(s2, src2);
                        const float c = w0[n][e] * p2 + w1[n][e] * p1 + w2[n][e] * G[e];
                        o[e] = silu_mul(c, V[e]);
                    }
                    if (n == 0) { pk.x = cvt_pk_bf16(o[0], o[1]); pk.y = cvt_pk_bf16(o[2], o[3]); } else { pk.z = cvt_pk_bf16(o[0], o[1]); pk.w = cvt_pk_bf16(o[2], o[3]); }
                }
                if (!(ai == 0 && m == 0 && wr == 0 && fr < 2)) *(u32x4*)(A + (size_t)row * FF + j0) = pk;
            }
        }
    }
};

template <class Epi>
__device__ __forceinline__ void gemm_phase(const Ctx cx, LAS unsigned char* lds, const Gemm g, const StaticOrder& S, const Epi& E) {
    const int tid = cx.tid, wid = __builtin_amdgcn_readfirstlane(tid >> 6), lane = tid & 63, wr = wid >> 2, wc = wid & 3, fr = lane & 15, fq = lane >> 4;
    const int nt = g.K / BK;
    unsigned voffA[2], voffB[2];
#pragma unroll
    for (int i = 0; i < 2; ++i) { int R, C; stage_rc(tid * 16 + i * 8192, R, C); const int Rb = (R & ~31) + perm32(R & 31);
        voffA[i] = (unsigned)(R * g.lda + C) * 2u; voffB[i] = (unsigned)(Rb * g.ldb + C) * 2u; }
    const size_t kstep = (size_t)(BK * 2);
    const size_t hstepA = (size_t)HALF * g.lda * 2, hstepB = (size_t)HALF * g.ldb * 2;
    const size_t tstepA = 2 * hstepA, tstepB = 2 * hstepB;
    const unsigned ldsw = (unsigned)wid * 1024u;
    const int aoff = lds_byte(wr * 64 + fr, fq * 8), boff = lds_byte(wc * 32 + fr, fq * 8);
#define PG8_SA(b, h) (((b) * 2 + (h)) * HTB)
#define PG8_SB(b, h) ((4 + (b) * 2 + (h)) * HTB)
#define PG8_STAGE(bufoff, gbase, voff) do { _Pragma("unroll") for (int _i = 0; _i < 2; ++_i) \
        __builtin_amdgcn_global_load_lds((const unsigned*)((const char*)(gbase) + (voff)[_i]), (LAS unsigned*)(lds + (bufoff) + ldsw + _i * 8192), 16, 0, 0); } while (0)
#define PG8_LDA(dst, b, h) do { _Pragma("unroll") for (int m = 0; m < 4; ++m) _Pragma("unroll") for (int k = 0; k < 2; ++k) dst[m][k] = *(const LAS bf16x8*)(lds + PG8_SA(b, h) + aoff + m * 2048 + k * 1024); } while (0)
#define PG8_LDB(dst, b, h) do { _Pragma("unroll") for (int n = 0; n < 2; ++n) _Pragma("unroll") for (int k = 0; k < 2; ++k) dst[n][k] = *(const LAS bf16x8*)(lds + PG8_SB(b, h) + boff + n * 2048 + k * 1024); } while (0)
#define PG8_MMA(ai, bj, At, Bt) do { __builtin_amdgcn_s_setprio(1); _Pragma("unroll") for (int m = 0; m < 4; ++m) _Pragma("unroll") for (int n = 0; n < 2; ++n) _Pragma("unroll") for (int k = 0; k < 2; ++k) \
        acc[ai][bj][m][n] = __builtin_amdgcn_mfma_f32_16x16x32_bf16(Bt[n][k], At[m][k], acc[ai][bj][m][n], 0, 0, 0); __builtin_amdgcn_s_setprio(0); } while (0)
#define PG8_WAIT_V(n) asm volatile("s_waitcnt vmcnt(" #n ")" ::: "memory")
#define PG8_WAIT_L(n) asm volatile("s_waitcnt lgkmcnt(" #n ")" ::: "memory")
#define PG8_BAR __builtin_amdgcn_s_barrier()
#define PG8_SCHED __builtin_amdgcn_sched_barrier(0)
    Unit cur, nxt; int ui = 0;
    if (!S.next(0, cur)) return;
    f32x4 acc[2][2][4][2];
#pragma unroll
    for (int a = 0; a < 2; ++a)
#pragma unroll
        for (int b = 0; b < 2; ++b)
#pragma unroll
            for (int m = 0; m < 4; ++m)
#pragma unroll
                for (int n = 0; n < 2; ++n) acc[a][b][m][n] = (f32x4){0.f, 0.f, 0.f, 0.f};
    bf16x8 At[4][2], B0[2][2], B1[2][2];
    const char* cA = (const char*)g.A + (size_t)cur.pm * tstepA + (size_t)cur.pn * g.a_pn_bytes; const char* cB = (const char*)g.Bt + (size_t)cur.pn * tstepB;
    PG8_STAGE(PG8_SB(0, 0), cB, voffB); PG8_STAGE(PG8_SA(0, 0), cA, voffA); PG8_STAGE(PG8_SB(0, 1), cB + hstepB, voffB); PG8_STAGE(PG8_SA(0, 1), cA + hstepA, voffA);
    if (wr == 1) PG8_BAR;
    PG8_WAIT_V(4); PG8_BAR;
    PG8_STAGE(PG8_SB(1, 0), cB + kstep, voffB); PG8_STAGE(PG8_SA(1, 0), cA + kstep, voffA); PG8_STAGE(PG8_SB(1, 1), cB + hstepB + kstep, voffB);
    PG8_WAIT_V(6); PG8_BAR;
    for (;;) {
        const bool has_next = S.next(ui + 1, nxt);
        const char* nA = has_next ? (const char*)g.A + (size_t)nxt.pm * tstepA + (size_t)nxt.pn * g.a_pn_bytes : cA; const char* nB = has_next ? (const char*)g.Bt + (size_t)nxt.pn * tstepB : cB;
        for (int t = 0; t < nt; t += 2) {
            const bool last = (t == nt - 2);
            const char* a1 = cA + (size_t)(t + 1) * kstep;
            const char* a2 = last ? nA : cA + (size_t)(t + 2) * kstep; const char* b2 = last ? nB : cB + (size_t)(t + 2) * kstep;
            const char* a3 = a2 + kstep; const char* b3 = b2 + kstep;
            PG8_LDB(B0, 0, 0); PG8_SCHED; PG8_LDA(At, 0, 0); PG8_STAGE(PG8_SA(1, 1), a1 + hstepA, voffA);
            PG8_WAIT_L(8); PG8_BAR; PG8_WAIT_L(0); PG8_MMA(0, 0, At, B0); PG8_BAR; PG8_SCHED;
            PG8_LDB(B1, 0, 1); PG8_STAGE(PG8_SB(0, 0), b2, voffB);
            PG8_BAR; PG8_WAIT_L(0); PG8_MMA(0, 1, At, B1); PG8_BAR;
            PG8_LDA(At, 0, 1); PG8_STAGE(PG8_SA(0, 0), a2, voffA);
            PG8_BAR; PG8_WAIT_L(0); PG8_MMA(1, 0, At, B0); PG8_BAR; PG8_SCHED;
            PG8_STAGE(PG8_SB(0, 1), b2 + hstepB, voffB);
            PG8_WAIT_V(6); PG8_BAR; PG8_MMA(1, 1, At, B1); PG8_BAR;
            PG8_LDB(B0, 1, 0); PG8_SCHED; PG8_LDA(At, 1, 0); PG8_STAGE(PG8_SA(0, 1), a2 + hstepA, voffA);
            PG8_WAIT_L(8); PG8_BAR; PG8_WAIT_L(0); PG8_MMA(0, 0, At, B0); PG8_BAR; PG8_SCHED;
            PG8_LDB(B1, 1, 1); PG8_STAGE(PG8_SB(1, 0), b3, voffB);
            PG8_BAR; PG8_WAIT_L(0); PG8_MMA(0, 1, At, B1); PG8_BAR;
            PG8_LDA(At, 1, 1); PG8_STAGE(PG8_SA(1, 0), a3, voffA);
            PG8_BAR; PG8_WAIT_L(0); PG8_MMA(1, 0, At, B0); PG8_BAR; PG8_SCHED;
            PG8_STAGE(PG8_SB(1, 1), b3 + hstepB, voffB);
            PG8_WAIT_V(6); PG8_BAR; PG8_MMA(1, 1, At, B1); PG8_BAR;
        }
        E(acc, cur, wr, wc, fr, fq, lds);
        if (!has_next) break;
#pragma unroll
        for (int a = 0; a < 2; ++a)
#pragma unroll
            for (int b = 0; b < 2; ++b)
#pragma unroll
                for (int m = 0; m < 4; ++m)
#pragma unroll
                    for (int n = 0; n < 2; ++n) acc[a][b][m][n] = (f32x4){0.f, 0.f, 0.f, 0.f};
        cur = nxt; cA = nA; cB = nB; ++ui;
    }
    PG8_WAIT_V(0);
    if (wr == 0) PG8_BAR;
    PG8_BAR;
#undef PG8_SA
#undef PG8_SB
#undef PG8_STAGE
#undef PG8_LDA
#undef PG8_LDB
#undef PG8_MMA
#undef PG8_WAIT_V
#undef PG8_WAIT_L
#undef PG8_BAR
#undef PG8_SCHED
}

__device__ __forceinline__ void tr_tile(const Ctx cx, const float* __restrict__ W, int ldw, int k0, int c0, const float* __restrict__ gain, bf16_t* __restrict__ out, int ldo, int n0, LAS float* t) {
    const int tid = cx.tid, tx = tid & 63, ty = tid >> 6;
#pragma unroll
    for (int kk = ty; kk < 64; kk += 8) { float v = W[(size_t)(k0 + kk) * ldw + c0 + tx]; if (gain) v *= gain[k0 + kk]; t[kk * 65 + tx] = v; }
    __syncthreads();
    const int n = tid >> 3, ks = tid & 7;
    float v[8];
#pragma unroll
    for (int i = 0; i < 8; ++i) v[i] = t[(ks * 8 + i) * 65 + n];
    u32x4 w; w.x = cvt_pk_bf16(v[0], v[1]); w.y = cvt_pk_bf16(v[2], v[3]); w.z = cvt_pk_bf16(v[4], v[5]); w.w = cvt_pk_bf16(v[6], v[7]);
    *(u32x4*)(out + (size_t)(n0 + n) * ldo + k0 + ks * 8) = w;
    __syncthreads();
}
__device__ void phase_prologue(const Ctx cx, const Params& p, LAS unsigned char* lds) {
    LAS float* t = (LAS float*)lds;
    bf16_t* wup = (bf16_t*)(p.ws + WS_WUP); bf16_t* wdn = (bf16_t*)(p.ws + WS_WDN); bf16_t* win = (bf16_t*)(p.ws + WS_WIN); bf16_t* wout = (bf16_t*)(p.ws + WS_WOUT); bf16_t* wp = (bf16_t*)(p.ws + WS_WP);
    constexpr int T_UP = 4 * 88 * 16, T_DN = 4 * 16 * 44, T_IN = 2 * 48 * 16, T_OUT = 2 * 16 * 16, T_P = 2 * 4 * 4 * 4, T_ALL = T_UP + T_DN + T_IN + T_OUT + T_P;
    for (int it = cx.bid; it < T_ALL; it += cx.nblk) {
        int i = it;
        if (i < T_UP) { const int L = i / (88 * 16), r = i % (88 * 16), nb = r / 16, kb = r % 16; const int n0 = nb * 64, chunk = n0 >> 7, pn = chunk >> 1, h = chunk & 1;
            tr_tile(cx, p.ffn_w_up + (size_t)L * DM * 2 * FF, 2 * FF, kb * 64, h * FF + pn * 128 + (n0 & 127), p.norm_g + (L * 4 + 2) * DM, wup + (size_t)L * 5632 * DM, DM, n0, t); continue; }
        i -= T_UP;
        if (i < T_DN) { const int L = i / (16 * 44), r = i % (16 * 44), nb = r / 44, kb = r % 44;
            tr_tile(cx, p.ffn_w_down + (size_t)L * FF * DM, DM, kb * 64, nb * 64, nullptr, wdn + (size_t)L * DM * FF, FF, nb * 64, t); continue; }
        i -= T_DN;
        if (i < T_IN) { const int j = i / (48 * 16), r = i % (48 * 16), nb = r / 16, kb = r % 16; const int n0 = nb * 64, chunk = n0 >> 7;
            const int c0 = (chunk < 16) ? (DM * (1 + (chunk & 1)) + (chunk >> 1) * 128 + (n0 & 127)) : ((chunk - 16) * 128 + (n0 & 127));
            tr_tile(cx, p.sc_w_in + (size_t)j * DM * 3 * DM, 3 * DM, kb * 64, c0, p.norm_g + ((2 * j + 1) * 4 + 0) * DM, win + (size_t)j * 3072 * DM, DM, n0, t); continue; }
        i -= T_IN;
        if (i < T_OUT) { const int j = i / 256, r = i % 256, nb = r / 16, kb = r % 16;
            tr_tile(cx, p.sc_w_out + (size_t)j * DM * DM, DM, kb * 64, nb * 64, nullptr, wout + (size_t)j * DM * DM, DM, nb * 64, t); continue; }
        i -= T_OUT;
        { const int j = i / 64, r = i % 64, gI = r / 16, nb = (r % 16) / 4, kb = r % 4;
            tr_tile(cx, p.pool_w + ((size_t)j * 4 + gI) * 256 * 256, 256, kb * 64, nb * 64, p.norm_g + ((2 * j) * 4 + 0) * DM + gI * 256, wp + ((size_t)j * 1024 + gI * 256) * 256, 256, nb * 64, t); }
    }
    const int wid = cx.tid >> 6, lane = cx.tid & 63;
    bf16_t* Hb = (bf16_t*)(p.ws + WS_HB); float* rstd = (float*)(p.ws + WS_RSTD);
    for (int row = cx.bid * 8 + wid; row < MROWS; row += cx.nblk * 8) {
        const int m = row - MREAL;
        const float* src = row < MREAL ? p.x + (size_t)row * DM : (m < NMETA ? p.meta + (size_t)m * DM : nullptr);
        float* h = hrow(p, row); float ss = 0.f;
#pragma unroll
        for (int c = 0; c < 4; ++c) {
            const int col = c * 256 + lane * 4;
            f32x4 v = src ? *(const f32x4*)(src + col) : (f32x4){0.f, 0.f, 0.f, 0.f};
            *(f32x4*)(h + col) = v; ss += (v[0] * v[0] + v[1] * v[1]) + (v[2] * v[2] + v[3] * v[3]);
            u32x2 w; w.x = cvt_pk_bf16(v[0], v[1]); w.y = cvt_pk_bf16(v[2], v[3]); *(u32x2*)(Hb + (size_t)row * DM + col) = w;
        }
        ss = wave_sum(ss);
        if (lane == 0) rstd[row] = 1.0f / sqrtf(ss * (1.0f / DM) + RMS_EPS);
    }
    if (cx.bid == 0) { float* ones = (float*)(p.ws + WS_ONES); for (int i = cx.tid; i < DM; i += 512) ones[i] = 1.0f; }
}

__device__ void phase_eres(const Ctx cx, const Params& p, const float* g, bool last) {
    const int wid = cx.tid >> 6, lane = cx.tid & 63;
    bf16_t* Hb = (bf16_t*)(p.ws + WS_HB); const bf16_t* F = (const bf16_t*)(p.ws + WS_F); float* rstd = (float*)(p.ws + WS_RSTD); const float* ssp = (const float*)(p.ws + WS_SSF);
    const int nrows = last ? MREAL : MROWS;
    f32x4 gv[4];
#pragma unroll
    for (int c = 0; c < 4; ++c) gv[c] = *(const f32x4*)(g + c * 256 + lane * 4);
    for (int row = cx.bid * 8 + wid; row < nrows; row += cx.nblk * 8) {
        float s = (lane < 16) ? ssp[(size_t)row * 16 + lane] : 0.f; s = wave_sum(s);
        const float rf = 1.0f / sqrtf(s * (1.0f / DM) + RMS_EPS);
        float* h = hrow(p, row); float ss = 0.f;
#pragma unroll
        for (int c = 0; c < 4; ++c) {
            const int col = c * 256 + lane * 4;
            f32x4 v = *(const f32x4*)(h + col); const u32x2 fw = *(const u32x2*)(F + (size_t)row * DM + col);
            v[0] += bf_lo(fw.x) * rf * gv[c][0]; v[1] += bf_hi(fw.x) * rf * gv[c][1]; v[2] += bf_lo(fw.y) * rf * gv[c][2]; v[3] += bf_hi(fw.y) * rf * gv[c][3];
            *(f32x4*)(h + col) = v; ss += (v[0] * v[0] + v[1] * v[1]) + (v[2] * v[2] + v[3] * v[3]);
            if (!last) { u32x2 w; w.x = cvt_pk_bf16(v[0], v[1]); w.y = cvt_pk_bf16(v[2], v[3]); *(u32x2*)(Hb + (size_t)row * DM + col) = w; }
        }
        if (!last) { ss = wave_sum(ss); if (lane == 0) rstd[row] = 1.0f / sqrtf(ss * (1.0f / DM) + RMS_EPS); }
    }
}
__device__ void phase_epool(const Ctx cx, const Params& p) {
    const bf16_t* Hb = (const bf16_t*)(p.ws + WS_HB); const float* rstd = (const float*)(p.ws + WS_RSTD); bf16_t* P = (bf16_t*)(p.ws + WS_ACT);
    const int tid = cx.tid, sub = tid >> 7, c0 = (tid & 127) * 8;
    const int w = 2 << (c0 >> 8);
    for (int row = cx.bid * 4 + sub; row < MROWS; row += cx.nblk * 4) {
        float acc[8], self[8]; int cnt = 0;
#pragma unroll
        for (int e = 0; e < 8; ++e) acc[e] = 0.f;
        for (int k = 0; k < w; ++k) {
            const int pr = prev_row(row, k); if (pr < 0) break;
            const float r = rstd[pr]; const u32x4 v = *(const u32x4*)(Hb + (size_t)pr * DM + c0);
            const float f[8] = {bf_lo(v.x) * r, bf_hi(v.x) * r, bf_lo(v.y) * r, bf_hi(v.y) * r, bf_lo(v.z) * r, bf_hi(v.z) * r, bf_lo(v.w) * r, bf_hi(v.w) * r};
#pragma unroll
            for (int e = 0; e < 8; ++e) { acc[e] += f[e]; if (k == 0) self[e] = f[e]; }
            ++cnt;
        }
        const float inv = 1.0f / (float)cnt;
        u32x4 o; o.x = cvt_pk_bf16(acc[0] * inv - self[0], acc[1] * inv - self[1]); o.y = cvt_pk_bf16(acc[2] * inv - self[2], acc[3] * inv - self[3]);
        o.z = cvt_pk_bf16(acc[4] * inv - self[4], acc[5] * inv - self[5]); o.w = cvt_pk_bf16(acc[6] * inv - self[6], acc[7] * inv - self[7]);
        *(u32x4*)(P + (size_t)row * DM + c0) = o;
    }
}
__device__ void phase_econv(const Ctx cx, const Params& p, const float* cw) {
    const bf16_t* CV = (const bf16_t*)(p.ws + WS_ACT); const bf16_t* Bb = CV + (size_t)MROWS * DM; bf16_t* Y = (bf16_t*)(p.ws + WS_ACT) + (size_t)2 * MROWS * DM;
    const int tid = cx.tid, sub = tid >> 7, c0 = (tid & 127) * 8;
    float w0[8], w1[8], w2[8];
#pragma unroll
    for (int e = 0; e < 8; ++e) { w0[e] = cw[c0 + e]; w1[e] = cw[DM + c0 + e]; w2[e] = cw[2 * DM + c0 + e]; }
    for (int row = cx.bid * 4 + sub; row < MROWS; row += cx.nblk * 4) {
        const int r1 = prev_row(row, 1), r2 = prev_row(row, 2);
        const u32x4 z = (u32x4){0u, 0u, 0u, 0u};
        const u32x4 x0 = *(const u32x4*)(CV + (size_t)row * DM + c0);
        const u32x4 x1 = r1 >= 0 ? *(const u32x4*)(CV + (size_t)r1 * DM + c0) : z;
        const u32x4 x2 = r2 >= 0 ? *(const u32x4*)(CV + (size_t)r2 * DM + c0) : z;
        const u32x4 bb = *(const u32x4*)(Bb + (size_t)row * DM + c0);
        float y[8];
#pragma unroll
        for (int e = 0; e < 4; ++e) {
            y[2 * e] = bf_lo(bb[e]) * (w0[2 * e] * bf_lo(x2[e]) + w1[2 * e] * bf_lo(x1[e]) + w2[2 * e] * bf_lo(x0[e]));
            y[2 * e + 1] = bf_hi(bb[e]) * (w0[2 * e + 1] * bf_hi(x2[e]) + w1[2 * e + 1] * bf_hi(x1[e]) + w2[2 * e + 1] * bf_hi(x0[e]));
        }
        u32x4 o; o.x = cvt_pk_bf16(y[0], y[1]); o.y = cvt_pk_bf16(y[2], y[3]); o.z = cvt_pk_bf16(y[4], y[5]); o.w = cvt_pk_bf16(y[6], y[7]);
        *(u32x4*)(Y + (size_t)row * DM + c0) = o;
    }
}
__device__ void fixup_rows(const Ctx cx, const Params& p, const StaticOrder& S, const float* cw) {
    bf16_t* A = (bf16_t*)(p.ws + WS_ACT); const float* hg = (const float*)(p.ws + WS_HG); const float* hr = (const float*)(p.ws + WS_HR);
    Unit u;
    for (int i = 0; S.next(i, u); ++i) {
        const int pm = u.pm;
        const float* src = (pm == META_TILE) ? nullptr : ((pm & 7) == 0 ? hg + (size_t)META_TILE * 2 * FF : hg + (size_t)(pm - 1) * 2 * FF);
        for (int j = cx.tid; j < FF; j += 512) {
            const float gm2 = src ? src[j] : 0.f, gm1 = src ? src[FF + j] : 0.f;
            const float g0 = hr[((size_t)pm * 2 + 0) * 2 * FF + j], v0 = hr[((size_t)pm * 2 + 0) * 2 * FF + FF + j];
            const float g1 = hr[((size_t)pm * 2 + 1) * 2 * FF + j], v1 = hr[((size_t)pm * 2 + 1) * 2 * FF + FF + j];
            const float k0 = cw[j], k1 = cw[FF + j], k2 = cw[2 * FF + j];
            const float c0 = k0 * gm2 + k1 * gm1 + k2 * g0, c1 = k0 * gm1 + k1 * g0 + k2 * g1;
            A[(size_t)(pm * BM) * FF + j] = (bf16_t)(cvt_pk_bf16(silu_mul(c0, v0), 0.f) & 0xffffu);
            A[(size_t)(pm * BM + 1) * FF + j] = (bf16_t)(cvt_pk_bf16(silu_mul(c1, v1), 0.f) & 0xffffu);
        }
    }
    __threadfence();
    __syncthreads();
}

enum { K_PRO = 0, K_EPOOL, K_GPOOL, K_ERES0, K_GUP, K_GDOWN, K_ERES1, K_GIN, K_ECONV, K_GOUT };
constexpr int N_PHASES = 27;
__device__ __forceinline__ void decode_phase(int ph, int& layer, int& kind) {
    if (ph == 0) { layer = 0; kind = K_PRO; return; }
    const int q = ph - 1, pair = q / 13, r = q % 13;
    if (r < 6) { layer = 2 * pair; kind = (r == 0) ? K_EPOOL : (r == 1) ? K_GPOOL : (r == 2) ? K_ERES0 : (r == 3) ? K_GUP : (r == 4) ? K_GDOWN : K_ERES1; }
    else { const int s = r - 6; layer = 2 * pair + 1; kind = (s == 0) ? K_GIN : (s == 1) ? K_ECONV : (s == 2) ? K_GOUT : (s == 3) ? K_ERES0 : (s == 4) ? K_GUP : (s == 5) ? K_GDOWN : K_ERES1; }
}

__global__ void __launch_bounds__(512, 2) mk_fwd(Params p_in) {
    extern __shared__ __attribute__((aligned(16))) unsigned char shm[];
    LAS unsigned char* lds = (LAS unsigned char*)shm;
    cg::grid_group grid = cg::this_grid();
    typedef const Params __attribute__((address_space(4)))* KArgPtr;
    const int ph_hi = p_in.ph_hi, coop = p_in.coop;
    for (int ph = p_in.ph_lo; ph < ph_hi; ++ph) {
        int layer, kind; decode_phase(ph, layer, kind);
        KArgPtr kp = (KArgPtr)__builtin_amdgcn_kernarg_segment_ptr();
        asm volatile("" : "+s"(layer), "+s"(kind), "+s"(kp));
        Params p;
        p.x = kp->x; p.meta = kp->meta; p.pool_w = kp->pool_w; p.pool_scale = kp->pool_scale; p.sc_w_in = kp->sc_w_in; p.sc_conv = kp->sc_conv; p.sc_w_out = kp->sc_w_out;
        p.ffn_w_up = kp->ffn_w_up; p.ffn_conv = kp->ffn_conv; p.ffn_w_down = kp->ffn_w_down; p.norm_g = kp->norm_g; p.out = kp->out; p.ws = kp->ws;
        p.ph_lo = 0; p.ph_hi = 0; p.coop = 0; p.pad = 0;
        unsigned char* wsb = p.ws;
        Ctx cx; cx.tid = threadIdx.x; cx.bid = blockIdx.x; cx.nblk = gridDim.x;
        asm volatile("" : "+v"(cx.tid), "+s"(cx.bid), "+s"(cx.nblk));
#ifdef ONLY_KIND
        kind = ONLY_KIND;
#endif
        bf16_t* Hb = (bf16_t*)(wsb + WS_HB); bf16_t* F = (bf16_t*)(wsb + WS_F); bf16_t* ACT = (bf16_t*)(wsb + WS_ACT);
        float* rstd = (float*)(wsb + WS_RSTD); float* ssp = (float*)(wsb + WS_SSF); const float* ones = (const float*)(wsb + WS_ONES);
        const int j = layer >> 1;
        StaticOrder S;
        switch (kind) {
        case K_PRO: phase_prologue(cx, p, lds); break;
        case K_EPOOL: phase_epool(cx, p); break;
        case K_ECONV: phase_econv(cx, p, p.sc_conv + (size_t)j * 3 * DM); break;
        case K_ERES0: phase_eres(cx, p, p.norm_g + (layer * 4 + 1) * DM, false); break;
        case K_ERES1: phase_eres(cx, p, p.norm_g + (layer * 4 + 3) * DM, layer == 3); break;
        case K_GPOOL: case K_GDOWN: case K_GOUT: {
            Gemm g; EpiF E; E.F = F; E.ssp = ssp;
            if (kind == K_GPOOL) { g = Gemm{ACT, (const bf16_t*)(p.ws + WS_WP) + (size_t)j * 1024 * 256, MROWS, DM, 256, DM, 256, 512}; E.scale = p.pool_scale + (size_t)j * DM; }
            else if (kind == K_GDOWN) { g = Gemm{ACT, (const bf16_t*)(p.ws + WS_WDN) + (size_t)layer * DM * FF, MROWS, DM, FF, FF, FF, 0}; E.scale = ones; }
            else { g = Gemm{ACT + (size_t)2 * MROWS * DM, (const bf16_t*)(p.ws + WS_WOUT) + (size_t)j * DM * DM, MROWS, DM, DM, DM, DM, 0}; E.scale = ones; }
            S.init(g.M, g.N, cx.nblk, cx.bid);
            if (kind == K_GDOWN) fixup_rows(cx, p, S, p.ffn_conv + (size_t)layer * 3 * FF);
            gemm_phase<EpiF>(cx, lds, g, S, E);
        } break;
        case K_GUP: {
            Gemm g{Hb, (const bf16_t*)(p.ws + WS_WUP) + (size_t)layer * 5632 * DM, MROWS, 5632, DM, DM, DM, 0};
            EpiUp E{ACT, rstd, p.ffn_conv + (size_t)layer * 3 * FF, (float*)(p.ws + WS_HG), (float*)(p.ws + WS_HR)};
            S.init(g.M, g.N, cx.nblk, cx.bid);
            gemm_phase<EpiUp>(cx, lds, g, S, E);
        } break;
        case K_GIN: {
            Gemm g{Hb, (const bf16_t*)(p.ws + WS_WIN) + (size_t)j * 3072 * DM, MROWS, 3072, DM, DM, DM, 0};
            EpiIn E{ACT, ACT + (size_t)MROWS * DM, rstd};
            S.init(g.M, g.N, cx.nblk, cx.bid);
            gemm_phase<EpiIn>(cx, lds, g, S, E);
        } break;
        }
        if (ph + 1 < ph_hi) { if (coop) grid.sync(); }
    }
}

extern "C" void kernel_launch(void* const* d_in, const int* in_sizes, int n_in, void* d_out, int out_size, void* d_ws, size_t ws_size, hipStream_t stream) {
    static int grid = 0;
    if (grid == 0) {
        if (n_in != 11 || out_size != MREAL * DM || ws_size < WS_END) { fprintf(stderr, "kernel_launch: unexpected shapes (n_in %d out %d ws %zu need %zu)\n", n_in, out_size, ws_size, (size_t)WS_END); grid = -1; return; }
        int dev = 0, cus = 0, per_cu = 0;
        hipGetDevice(&dev); hipDeviceGetAttribute(&cus, hipDeviceAttributeMultiprocessorCount, dev);
        if (hipFuncSetAttribute((const void*)mk_fwd, hipFuncAttributeMaxDynamicSharedMemorySize, LDS_BYTES) != hipSuccess) { fprintf(stderr, "kernel_launch: hipFuncSetAttribute failed\n"); grid = -1; return; }
        if (hipOccupancyMaxActiveBlocksPerMultiprocessor(&per_cu, (const void*)mk_fwd, 512, LDS_BYTES) != hipSuccess || per_cu < 1) { fprintf(stderr, "kernel_launch: occupancy query says %d\n", per_cu); per_cu = 1; }
        (void)hipGetLastError();
        grid = cus * 1;
    }
    if (grid < 0) return;
    Params p{};
    p.x = (const float*)d_in[0]; p.meta = (const float*)d_in[1]; p.pool_w = (const float*)d_in[2]; p.pool_scale = (const float*)d_in[3]; p.sc_w_in = (const float*)d_in[4];
    p.sc_conv = (const float*)d_in[5]; p.sc_w_out = (const float*)d_in[6]; p.ffn_w_up = (const float*)d_in[7]; p.ffn_conv = (const float*)d_in[8]; p.ffn_w_down = (const float*)d_in[9];
    p.norm_g = (const float*)d_in[10]; p.out = (float*)d_out; p.ws = (unsigned char*)d_ws;
#if MK_ONE_LAUNCH
    p.ph_lo = 0; p.ph_hi = N_PHASES; p.coop = 1;
    void* args[] = {&p};
    hipError_t e = hipLaunchCooperativeKernel((const void*)mk_fwd, dim3(grid), dim3(512), args, LDS_BYTES, stream);
    if (e != hipSuccess) fprintf(stderr, "kernel_launch: cooperative launch failed: %s (grid %d)\n", hipGetErrorString(e), grid);
#else
    for (int ph = 0; ph < N_PHASES; ++ph) {
        p.ph_lo = ph; p.ph_hi = ph + 1; p.coop = 0;
        hipLaunchKernelGGL(mk_fwd, dim3(grid), dim3(512), LDS_BYTES, stream, p);
    }
#endif
}
```

```cpp
#include <hip/hip_runtime.h>
#include <hip/hip_cooperative_groups.h>
#include <cstdio>
namespace cg = cooperative_groups;

#ifndef MK_ONE_LAUNCH
#define MK_ONE_LAUNCH 1
#endif

#define LAS __attribute__((address_space(3)))
typedef unsigned short bf16_t;
typedef short bf16x8 __attribute__((ext_vector_type(8)));
typedef float f32x4 __attribute__((ext_vector_type(4)));
typedef unsigned u32x4 __attribute__((ext_vector_type(4)));
typedef unsigned u32x2 __attribute__((ext_vector_type(2)));

constexpr int DM = 1024, FF = 2816, SEQ = 2048, NB = 16, NMETA = 16;
constexpr int MREAL = NB * SEQ;
constexpr int MROWS = MREAL + 256;
constexpr int NTM = MROWS / 256;
constexpr int NVROWS = MREAL + NMETA;
constexpr int META_TILE = MREAL / 256;
constexpr float RMS_EPS = 1e-6f;

constexpr int BM = 256, BK = 64, HALF = 128, HTB = HALF * BK * 2, STAGE_BYTES = 8 * HTB, NXCD = 8, WGM = 8;
constexpr int XCH_BYTES = 4 * 2 * 128 * 4;
constexpr int PA_STRIDE_B = 2064;
constexpr int PM_A_BYTES = 64 * PA_STRIDE_B, PM_RED_OFF = PM_A_BYTES, PM_BYTES = PM_A_BYTES + 2 * 64 * 8 * 4;
constexpr int XBST_OFF = (STAGE_BYTES + XCH_BYTES) > PM_BYTES ? (STAGE_BYTES + XCH_BYTES) : PM_BYTES;
constexpr int LDS_BYTES = XBST_OFF + 16;

constexpr size_t al256(size_t x) { return (x + 255) & ~(size_t)255; }
constexpr size_t WS_HB    = 0;
constexpr size_t WS_F     = WS_HB + al256((size_t)MROWS * DM * 2);
constexpr size_t WS_ACT   = WS_F + al256((size_t)MROWS * DM * 2);
constexpr size_t WS_WUP   = WS_ACT + al256((size_t)MROWS * 3072 * 2);
constexpr size_t WS_WDN   = WS_WUP + al256((size_t)4 * 5632 * 1024 * 2);
constexpr size_t WS_WIN   = WS_WDN + al256((size_t)4 * 1024 * 2816 * 2);
constexpr size_t WS_WOUT  = WS_WIN + al256((size_t)2 * 3072 * 1024 * 2);
constexpr size_t WS_WP    = WS_WOUT + al256((size_t)2 * 1024 * 1024 * 2);
constexpr size_t WS_HMETA = WS_WP + al256((size_t)2 * 1024 * 256 * 2);
constexpr size_t WS_RSTD  = WS_HMETA + al256((size_t)256 * DM * 4);
constexpr size_t WS_SSF   = WS_RSTD + al256((size_t)MROWS * 4);
constexpr size_t WS_HG    = WS_SSF + al256((size_t)MROWS * 16 * 4);
constexpr size_t WS_HR    = WS_HG + al256((size_t)NTM * 2 * FF * 4);
constexpr size_t WS_ONES  = WS_HR + al256((size_t)NTM * 4 * FF * 4);
constexpr size_t WS_SSM   = WS_ONES + al256((size_t)DM * 4);
constexpr size_t WS_BAR   = WS_SSM + al256((size_t)16 * 32 * 4);
constexpr size_t WS_HB2   = WS_BAR + 16384;
constexpr size_t WS_RSTD2 = WS_HB2 + al256((size_t)MROWS * DM * 2);
constexpr size_t WS_END   = WS_RSTD2 + al256((size_t)MROWS * 4);
static_assert(WS_END <= (size_t)536870912, "workspace map exceeds 4x the largest tensor");

struct Params {
    const float* x; const float* meta; const float* pool_w; const float* pool_scale; const float* sc_w_in; const float* sc_conv; const float* sc_w_out;
    const float* ffn_w_up; const float* ffn_conv; const float* ffn_w_down; const float* norm_g;
    float* out; unsigned char* ws; int ph_lo, ph_hi, coop, pad;
};

__device__ __forceinline__ unsigned cvt_pk_bf16(float lo, float hi) { unsigned r; asm("v_cvt_pk_bf16_f32 %0, %1, %2" : "=v"(r) : "v"(lo), "v"(hi)); return r; }
__device__ __forceinline__ float bf_lo(unsigned w) { return __uint_as_float(w << 16); }
__device__ __forceinline__ float bf_hi(unsigned w) { return __uint_as_float(w & 0xffff0000u); }
__device__ __forceinline__ float wave_sum(float v) {
    v += __int_as_float(__builtin_amdgcn_update_dpp(0, __float_as_int(v), 0x111, 0xf, 0xf, true));
    v += __int_as_float(__builtin_amdgcn_update_dpp(0, __float_as_int(v), 0x112, 0xf, 0xf, true));
    v += __int_as_float(__builtin_amdgcn_update_dpp(0, __float_as_int(v), 0x114, 0xf, 0xf, true));
    v += __int_as_float(__builtin_amdgcn_update_dpp(0, __float_as_int(v), 0x118, 0xf, 0xf, true));
    const int vi = __float_as_int(v);
    return (__int_as_float(__builtin_amdgcn_readlane(vi, 15)) + __int_as_float(__builtin_amdgcn_readlane(vi, 31)))
         + (__int_as_float(__builtin_amdgcn_readlane(vi, 47)) + __int_as_float(__builtin_amdgcn_readlane(vi, 63)));
}
__device__ __forceinline__ int prev_row(int row, int k) {
    if (row < MREAL) { const int t = row & (SEQ - 1); return (t >= k) ? row - k : MREAL + NMETA + t - k; }
    const int m = row - MREAL; return (m >= k) ? row - k : -1;
}
__device__ __forceinline__ float* hrow(const Params& p, int row) { return row < MREAL ? p.out + (size_t)row * DM : (float*)(p.ws + WS_HMETA) + (size_t)(row - MREAL) * DM; }
template <int CTRL> __device__ __forceinline__ float dpp_f32(float v) { return __int_as_float(__builtin_amdgcn_update_dpp(0, __float_as_int(v), CTRL, 0xf, 0xf, true)); }
__device__ __forceinline__ float silu_mul(float c, float v) { return c * __builtin_amdgcn_rcpf(1.0f + __builtin_amdgcn_exp2f(-1.44269504089f * c)) * v; }

#define XB_TMO      128
#define XB_XCNT(j)  (256  + 64 * (j))
#define XB_XSUB(j)  (1280 + 64 * (j))
#define XB_XGEN(j)  (2304 + 64 * (j))
#define XB_TOP      3328
#define XB_TOPGEN   3392
#define XCD_BAR_WORDS 3456
#define XB_SPIN_CAP (1u << 22)
__device__ __forceinline__ unsigned xb_ld(unsigned* p)              { return __hip_atomic_load(p, __ATOMIC_RELAXED, __HIP_MEMORY_SCOPE_AGENT); }
__device__ __forceinline__ unsigned xb_add(unsigned* p, unsigned v) { return __hip_atomic_fetch_add(p, v, __ATOMIC_RELAXED, __HIP_MEMORY_SCOPE_AGENT); }
__device__ __forceinline__ unsigned xb_xcc_id() { return (unsigned)__builtin_amdgcn_s_getreg((3 << 11) | 20) & 0xFu; }
#define XB_SPIN(cond, bar) do { unsigned _sp = 0; while (cond) { __builtin_amdgcn_s_sleep(1); \
    if ((++_sp & 255u) == 0u) { if (xb_ld(&(bar)[XB_TMO])) break; if (_sp > XB_SPIN_CAP) { atomicAdd(&(bar)[XB_TMO], 1u); break; } } } } while (0)
struct XcdBarrier { unsigned* bar; unsigned x; volatile LAS unsigned* st; };
__device__ __forceinline__ void xcd_barrier_complete(unsigned* bar, unsigned x, unsigned G, unsigned& nloc, unsigned& nx) {
    unsigned sum, cnt, mine, sp = 0u;
    for (;;) {
        sum = 0u; cnt = 0u; mine = 0u;
#pragma unroll
        for (unsigned j = 0; j < 16; ++j) { const unsigned c = xb_ld(&bar[XB_XCNT(j)]); sum += c; cnt += (c > 0u) ? 1u : 0u; mine = (j == x) ? c : mine; }
        if (sum == G) break;
        __builtin_amdgcn_s_sleep(1);
        if ((++sp & 255u) == 0u) { if (xb_ld(&bar[XB_TMO])) break; if (sp > XB_SPIN_CAP) { atomicAdd(&bar[XB_TMO], 1u); break; } }
    }
    nloc = mine > 0u ? mine : 1u; nx = cnt > 0u ? cnt : 1u;
}
__device__ __forceinline__ void xcd_barrier(const XcdBarrier& b, int tid, unsigned G) {
    asm volatile("s_waitcnt vmcnt(0)" ::: "memory");
    __syncthreads();
    if (tid == 0) {
        unsigned* bar = b.bar;
        __builtin_amdgcn_s_waitcnt(0);
        unsigned nloc = b.st[0], nx = b.st[1];
        if (nloc == 0u) { xcd_barrier_complete(bar, b.x, G, nloc, nx); b.st[0] = nloc; b.st[1] = nx; }
        const unsigned old = xb_add(&bar[XB_XSUB(b.x)], 1u);
        const unsigned gen = old / nloc;
        if (old + 1u == (gen + 1u) * nloc) {
            __builtin_amdgcn_fence(__ATOMIC_RELEASE, "agent");
            asm volatile("s_waitcnt vmcnt(0)" ::: "memory");
            const unsigned og = xb_add(&bar[XB_TOP], 1u);
            const unsigned tg = og / nx;
            if (og + 1u == (tg + 1u) * nx) xb_add(&bar[XB_TOPGEN], 1u);
            else XB_SPIN(xb_ld(&bar[XB_TOPGEN]) == tg, bar);
            __builtin_amdgcn_fence(__ATOMIC_ACQUIRE, "agent");
            xb_add(&bar[XB_XGEN(b.x)], 1u);
            asm volatile("s_waitcnt vmcnt(0)" ::: "memory");
        } else {
            XB_SPIN(xb_ld(&bar[XB_XGEN(b.x)]) == gen, bar);
            __builtin_amdgcn_fence(__ATOMIC_ACQUIRE, "agent");
            asm volatile("s_waitcnt vmcnt(0)" ::: "memory");
        }
    }
    __syncthreads();
}

__device__ __forceinline__ int lds_byte(int r, int c) { const int st = (r >> 4) * 2 + (c >> 5), rr = r & 15, cc = c & 31, ob = rr * 64 + cc * 2; return st * 1024 + (ob ^ (((ob >> 9) & 1) << 5)); }
__device__ __forceinline__ void stage_rc(int b, int& R, int& C) { const int st = b / 1024, sb = b % 1024, swz = sb ^ (((sb >> 9) & 1) << 5); R = (st >> 1) * 16 + swz / 64; C = (st & 1) * 32 + (swz % 64) / 2; }
__device__ __forceinline__ int perm32(int rho) { const int n = rho >> 4, i = rho & 15; return 8 * (i >> 2) + 4 * n + (i & 3); }

struct Ctx { int tid, bid, nblk; };
__device__ __forceinline__ void lds_barrier() { asm volatile("s_waitcnt lgkmcnt(0)" ::: "memory"); __builtin_amdgcn_s_barrier(); asm volatile("" ::: "memory"); }
struct Unit { int pm, pn; };
struct Gemm { const bf16_t* A; const bf16_t* Bt; int M, N, K, lda, ldb, a_pn_bytes; };

struct StaticOrder {
    int nM, nN, nwg, G, c;
    __device__ void init(int M, int N, int G_, int c_) { nM = M / BM; nN = N / BM; nwg = nM * nN; G = G_; c = c_; }
    __device__ bool next(int i, Unit& u) const {
        const long L = (long)i * G + c; if (L >= nwg) return false;
        int wgid = (int)L; { const int q = nwg / NXCD, r = nwg % NXCD, xcd = wgid % NXCD, off = wgid / NXCD; wgid = (xcd < r ? xcd * (q + 1) : r * (q + 1) + (xcd - r) * q) + off; }
        const int nig = WGM * nN, gid = wgid / nig, fm = gid * WGM, gsz = (nM - fm) < WGM ? (nM - fm) : WGM;
        u.pm = fm + ((wgid % nig) % gsz); u.pn = (wgid % nig) / gsz; return true;
    }
};

struct EpiF {
    bf16_t* F; float* ssp; const float* scale;
    __device__ __forceinline__ void operator()(f32x4 (&acc)[2][2][4][2], const Unit& u, int wr, int wc, int fr, int fq, LAS unsigned char*) const {
        asm volatile("" : "+v"(fr), "+v"(fq), "+s"(wr), "+s"(wc));
        const int row0 = u.pm * BM + wr * 64 + fr, col0 = u.pn * BM + wc * 32 + 8 * fq;
        f32x4 sc[2][2];
#pragma unroll
        for (int bj = 0; bj < 2; ++bj)
#pragma unroll
            for (int n = 0; n < 2; ++n) sc[bj][n] = *(const f32x4*)(scale + col0 + bj * HALF + 4 * n);
#pragma unroll
        for (int ai = 0; ai < 2; ++ai)
#pragma unroll
            for (int m = 0; m < 4; ++m) {
                const int row = row0 + ai * HALF + m * 16; float s = 0.f;
#pragma unroll
                for (int bj = 0; bj < 2; ++bj) {
                    const f32x4 v0 = acc[ai][bj][m][0] * sc[bj][0], v1 = acc[ai][bj][m][1] * sc[bj][1];
                    s += (v0[0] * v0[0] + v0[1] * v0[1]) + (v0[2] * v0[2] + v0[3] * v0[3]) + (v1[0] * v1[0] + v1[1] * v1[1]) + (v1[2] * v1[2] + v1[3] * v1[3]);
                    u32x4 w; w.x = cvt_pk_bf16(v0[0], v0[1]); w.y = cvt_pk_bf16(v0[2], v0[3]); w.z = cvt_pk_bf16(v1[0], v1[1]); w.w = cvt_pk_bf16(v1[2], v1[3]);
                    *(u32x4*)(F + (size_t)row * DM + col0 + bj * HALF) = w;
                }
                s += __shfl_xor(s, 16); s += __shfl_xor(s, 32);
                if (fq == 0) ssp[(size_t)row * 16 + u.pn * 4 + wc] = s;
            }
    }
};
struct EpiIn {
    bf16_t* CV; bf16_t* Bb; const float* rstd;
    __device__ __forceinline__ void operator()(f32x4 (&acc)[2][2][4][2], const Unit& u, int wr, int wc, int fr, int fq, LAS unsigned char*) const {
        asm volatile("" : "+v"(fr), "+v"(fq), "+s"(wr), "+s"(wc));
        const int row0 = u.pm * BM + wr * 64 + fr;
        float rs[2][4];
#pragma unroll
        for (int ai = 0; ai < 2; ++ai)
#pragma unroll
            for (int m = 0; m < 4; ++m) rs[ai][m] = rstd[row0 + ai * HALF + m * 16];
        if (u.pn < 8) {
            const int col0 = u.pn * HALF + wc * 32 + 8 * fq;
#pragma unroll
            for (int ai = 0; ai < 2; ++ai)
#pragma unroll
                for (int m = 0; m < 4; ++m) {
                    const int row = row0 + ai * HALF + m * 16; const float r2 = rs[ai][m] * rs[ai][m];
                    const f32x4 v0 = acc[ai][0][m][0] * acc[ai][1][m][0] * r2, v1 = acc[ai][0][m][1] * acc[ai][1][m][1] * r2;
                    u32x4 w; w.x = cvt_pk_bf16(v0[0], v0[1]); w.y = cvt_pk_bf16(v0[2], v0[3]); w.z = cvt_pk_bf16(v1[0], v1[1]); w.w = cvt_pk_bf16(v1[2], v1[3]);
                    *(u32x4*)(CV + (size_t)row * DM + col0) = w;
                }
        } else {
            const int col0 = (u.pn - 8) * BM + wc * 32 + 8 * fq;
#pragma unroll
            for (int ai = 0; ai < 2; ++ai)
#pragma unroll
                for (int m = 0; m < 4; ++m) {
                    const int row = row0 + ai * HALF + m * 16; const float r = rs[ai][m];
#pragma unroll
                    for (int bj = 0; bj < 2; ++bj) {
                        const f32x4 v0 = acc[ai][bj][m][0] * r, v1 = acc[ai][bj][m][1] * r;
                        u32x4 w; w.x = cvt_pk_bf16(v0[0], v0[1]); w.y = cvt_pk_bf16(v0[2], v0[3]); w.z = cvt_pk_bf16(v1[0], v1[1]); w.w = cvt_pk_bf16(v1[2], v1[3]);
                        *(u32x4*)(Bb + (size_t)row * DM + col0 + bj * HALF) = w;
                    }
                }
        }
    }
};
struct EpiUp {
    bf16_t* A; const float* rstd; const float* cw; float* hg; float* hr;
    __device__ __forceinline__ void operator()(f32x4 (&acc)[2][2][4][2], const Unit& u, int wr, int wc, int fr, int fq, LAS unsigned char* lds) const {
        asm volatile("" : "+v"(fr), "+v"(fq), "+s"(wr), "+s"(wc));
        LAS float* X = (LAS float*)(lds + STAGE_BYTES);
        const int lane = fq * 16 + fr;
        const int jl = wc * 32 + 8 * fq, j0 = u.pn * HALF + jl, rowt = wr * 64 + fr;
        float rs[2][4];
#pragma unroll
        for (int ai = 0; ai < 2; ++ai)
#pragma unroll
            for (int m = 0; m < 4; ++m) rs[ai][m] = rstd[u.pm * BM + ai * HALF + m * 16 + rowt];
        f32x4 w0[2], w1[2], w2[2];
#pragma unroll
        for (int n = 0; n < 2; ++n) { w0[n] = *(const f32x4*)(cw + j0 + 4 * n); w1[n] = *(const f32x4*)(cw + FF + j0 + 4 * n); w2[n] = *(const f32x4*)(cw + 2 * FF + j0 + 4 * n); }
#pragma unroll
        for (int ai = 0; ai < 2; ++ai)
#pragma unroll
            for (int m = 0; m < 4; ++m) {
#pragma unroll
                for (int bj = 0; bj < 2; ++bj)
#pragma unroll
                    for (int n = 0; n < 2; ++n) acc[ai][bj][m][n] *= rs[ai][m];
            }
        const bool meta = (u.pm == META_TILE);
        if (fr >= 14) {
#pragma unroll
            for (int ai = 0; ai < 2; ++ai)
#pragma unroll
                for (int n = 0; n < 2; ++n) *(LAS f32x4*)(X + ((2 * ai + wr) * 2 + (fr - 14)) * 128 + jl + 4 * n) = acc[ai][0][3][n];
            if (meta) { if (wr == 0) {
#pragma unroll
                for (int n = 0; n < 2; ++n) *(f32x4*)(hg + ((size_t)u.pm * 2 + (fr - 14)) * FF + j0 + 4 * n) = acc[0][0][0][n]; }
            } else if (wr == 1) {
#pragma unroll
                for (int n = 0; n < 2; ++n) *(f32x4*)(hg + ((size_t)u.pm * 2 + (fr - 14)) * FF + j0 + 4 * n) = acc[1][0][3][n];
            }
        }
        if (fr < 2 && wr == 0) {
#pragma unroll
            for (int n = 0; n < 2; ++n) {
                *(f32x4*)(hr + (((size_t)u.pm * 2 + fr) * 2 + 0) * FF + j0 + 4 * n) = acc[0][0][0][n];
                *(f32x4*)(hr + (((size_t)u.pm * 2 + fr) * 2 + 1) * FF + j0 + 4 * n) = acc[0][1][0][n];
            }
        }
        asm volatile("s_waitcnt lgkmcnt(0)" ::: "memory"); __builtin_amdgcn_s_barrier(); asm volatile("" ::: "memory");
        f32x4 w1b[2], w0b[2];
#pragma unroll
        for (int n = 0; n < 2; ++n)
#pragma unroll
            for (int e = 0; e < 4; ++e) { w1b[n][e] = (fr == 0) ? w1[n][e] : 0.f; w0b[n][e] = (fr < 2) ? w0[n][e] : 0.f; }
#pragma unroll
        for (int ai = 0; ai < 2; ++ai) {
            const int q = 2 * ai + wr;
            f32x4 gp[2];
#pragma unroll
            for (int n = 0; n < 2; ++n) { gp[n] = (f32x4){0.f, 0.f, 0.f, 0.f}; if (q > 0 && fr >= 14) gp[n] = *(LAS f32x4*)(X + ((q - 1) * 2 + (fr - 14)) * 128 + jl + 4 * n); }
#pragma unroll
            for (int m = 0; m < 4; ++m) {
                const int row = u.pm * BM + ai * HALF + m * 16 + rowt;
                u32x4 pk;
#pragma unroll
                for (int n = 0; n < 2; ++n) {
                    const f32x4 G = acc[ai][0][m][n], Gp = (m == 0) ? gp[n] : acc[ai][0][m == 0 ? 0 : m - 1][n], V = acc[ai][1][m][n];
                    f32x4 o;
#pragma unroll
                    for (int e = 0; e < 4; ++e) {
                        float c = w2[n][e] * G[e];
                        asm("s_nop 1\n\tv_fmac_f32_dpp %0, %1, %2 row_shr:1 row_mask:0xf bank_mask:0xf bound_ctrl:1" : "+v"(c) : "v"(G[e]), "v"(w1[n][e]));
                        asm("v_fmac_f32_dpp %0, %1, %2 row_shr:2 row_mask:0xf bank_mask:0xf bound_ctrl:1" : "+v"(c) : "v"(G[e]), "v"(w0[n][e]));
                        asm("s_nop 1\n\tv_fmac_f32_dpp %0, %1, %2 row_ror:1 row_mask:0xf bank_mask:0xf bound_ctrl:1" : "+v"(c) : "v"(Gp[e]), "v"(w1b[n][e]));
                        asm("v_fmac_f32_dpp %0, %1, %2 row_ror:2 row_mask:0xf bank_mask:0xf bound_ctrl:1" : "+v"(c) : "v"(Gp[e]), "v"(w0b[n][e]));
                        o[e] = silu_mul(c, V[e]);
                    }
                    if (n == 0) { pk.x = cvt_pk_bf16(o[0], o[1]); pk.y = cvt_pk_bf16(o[2], o[3]); } else { pk.z = cvt_pk_bf16(o[0], o[1]); pk.w = cvt_pk_bf16(o[2], o[3]); }
                }
                if (!(ai == 0 && m == 0 && wr == 0 && fr < 2)) *(u32x4*)(A + (size_t)row * FF + j0) = pk;
            }
        }
    }
};

template <class Epi>
__device__ __forceinline__ void gemm_phase(const Ctx cx, LAS unsigned char* lds, const Gemm g, const StaticOrder& S, const Epi& E) {
    const int tid = cx.tid, wid = __builtin_amdgcn_readfirstlane(tid >> 6), lane = tid & 63, wr = wid >> 2, wc = wid & 3, fr = lane & 15, fq = lane >> 4;
    const int nt = g.K / BK;
    unsigned voffA[2], voffB[2];
#pragma unroll
    for (int i = 0; i < 2; ++i) { int R, C; stage_rc(tid * 16 + i * 8192, R, C); const int Rb = (R & ~31) + perm32(R & 31);
        voffA[i] = (unsigned)(R * g.lda + C) * 2u; voffB[i] = (unsigned)(Rb * g.ldb + C) * 2u; }
    const size_t kstep = (size_t)(BK * 2);
    const size_t hstepA = (size_t)HALF * g.lda * 2, hstepB = (size_t)HALF * g.ldb * 2;
    const size_t tstepA = 2 * hstepA, tstepB = 2 * hstepB;
    const unsigned ldsw = (unsigned)wid * 1024u;
    const int aoff = lds_byte(wr * 64 + fr, fq * 8), boff = lds_byte(wc * 32 + fr, fq * 8);
#define PG8_SA(b, h) (((b) * 2 + (h)) * HTB)
#define PG8_SB(b, h) ((4 + (b) * 2 + (h)) * HTB)
#define PG8_STAGE(bufoff, gbase, voff) do { _Pragma("unroll") for (int _i = 0; _i < 2; ++_i) \
        __builtin_amdgcn_global_load_lds((const unsigned*)((const char*)(gbase) + (voff)[_i]), (LAS unsigned*)(lds + (bufoff) + ldsw + _i * 8192), 16, 0, 0); } while (0)
#define PG8_LDA(dst, b, h) do { _Pragma("unroll") for (int m = 0; m < 4; ++m) _Pragma("unroll") for (int k = 0; k < 2; ++k) dst[m][k] = *(const LAS bf16x8*)(lds + PG8_SA(b, h) + aoff + m * 2048 + k * 1024); } while (0)
#define PG8_LDB(dst, b, h) do { _Pragma("unroll") for (int n = 0; n < 2; ++n) _Pragma("unroll") for (int k = 0; k < 2; ++k) dst[n][k] = *(const LAS bf16x8*)(lds + PG8_SB(b, h) + boff + n * 2048 + k * 1024); } while (0)
#define PG8_MMA1(ai, bj, At, Bt) do { _Pragma("unroll") for (int m = 0; m < 4; ++m) _Pragma("unroll") for (int n = 0; n < 2; ++n) _Pragma("unroll") for (int k = 0; k < 2; ++k) \
        acc[ai][bj][m][n] = __builtin_amdgcn_mfma_f32_16x16x32_bf16(Bt[n][k], At[m][k], acc[ai][bj][m][n], 0, 0, 0); } while (0)
#define PG8_MMA2(ai, At, Ba, Bb) do { __builtin_amdgcn_s_setprio(1); PG8_MMA1(ai, 0, At, Ba); PG8_MMA1(ai, 1, At, Bb); __builtin_amdgcn_s_setprio(0); } while (0)
#define PG8_WAIT_V(n) asm volatile("s_waitcnt vmcnt(" #n ")" ::: "memory")
#define PG8_WAIT_L(n) asm volatile("s_waitcnt lgkmcnt(" #n ")" ::: "memory")
#define PG8_BAR __builtin_amdgcn_s_barrier()
#define PG8_SCHED __builtin_amdgcn_sched_barrier(0)
    Unit cur, nxt; int ui = 0;
    if (!S.next(0, cur)) return;
    f32x4 acc[2][2][4][2];
#pragma unroll
    for (int a = 0; a < 2; ++a)
#pragma unroll
        for (int b = 0; b < 2; ++b)
#pragma unroll
            for (int m = 0; m < 4; ++m)
#pragma unroll
                for (int n = 0; n < 2; ++n) acc[a][b][m][n] = (f32x4){0.f, 0.f, 0.f, 0.f};
    bf16x8 At[4][2], B0[2][2], B1[2][2];
    const char* cA = (const char*)g.A + (size_t)cur.pm * tstepA + (size_t)cur.pn * g.a_pn_bytes; const char* cB = (const char*)g.Bt + (size_t)cur.pn * tstepB;
    PG8_STAGE(PG8_SB(0, 0), cB, voffB); PG8_STAGE(PG8_SB(0, 1), cB + hstepB, voffB); PG8_STAGE(PG8_SA(0, 0), cA, voffA); PG8_STAGE(PG8_SA(0, 1), cA + hstepA, voffA);
    if (wr == 1) PG8_BAR;
    PG8_WAIT_V(2); PG8_BAR;
    PG8_STAGE(PG8_SB(1, 0), cB + kstep, voffB); PG8_STAGE(PG8_SA(1, 0), cA + kstep, voffA); PG8_STAGE(PG8_SB(1, 1), cB + hstepB + kstep, voffB);
    PG8_WAIT_V(6); PG8_BAR;
    for (;;) {
        const bool has_next = S.next(ui + 1, nxt);
        const char* nA = has_next ? (const char*)g.A + (size_t)nxt.pm * tstepA + (size_t)nxt.pn * g.a_pn_bytes : cA; const char* nB = has_next ? (const char*)g.Bt + (size_t)nxt.pn * tstepB : cB;
        for (int t = 0; t < nt; t += 2) {
            const bool last = (t == nt - 2);
            const char* a1 = cA + (size_t)(t + 1) * kstep;
            const char* a2 = last ? nA : cA + (size_t)(t + 2) * kstep; const char* b2 = last ? nB : cB + (size_t)(t + 2) * kstep;
            const char* a3 = a2 + kstep; const char* b3 = b2 + kstep;
            PG8_LDB(B0, 0, 0); PG8_LDB(B1, 0, 1); PG8_SCHED; PG8_LDA(At, 0, 0); PG8_STAGE(PG8_SA(1, 1), a1 + hstepA, voffA);
            PG8_WAIT_V(8); PG8_WAIT_L(0); PG8_BAR; PG8_MMA2(0, At, B0, B1); PG8_BAR; PG8_SCHED;
            PG8_LDA(At, 0, 1); PG8_STAGE(PG8_SB(0, 0), b2, voffB); PG8_STAGE(PG8_SB(0, 1), b2 + hstepB, voffB); PG8_STAGE(PG8_SA(0, 0), a2, voffA);
            PG8_WAIT_V(8); PG8_WAIT_L(0); PG8_BAR; PG8_MMA2(1, At, B0, B1); PG8_BAR; PG8_SCHED;
            PG8_LDB(B0, 1, 0); PG8_LDB(B1, 1, 1); PG8_SCHED; PG8_LDA(At, 1, 0); PG8_STAGE(PG8_SA(0, 1), a2 + hstepA, voffA);
            PG8_WAIT_V(8); PG8_WAIT_L(0); PG8_BAR; PG8_MMA2(0, At, B0, B1); PG8_BAR; PG8_SCHED;
            PG8_LDA(At, 1, 1); PG8_STAGE(PG8_SB(1, 0), b3, voffB); PG8_STAGE(PG8_SB(1, 1), b3 + hstepB, voffB); PG8_STAGE(PG8_SA(1, 0), a3, voffA);
            PG8_WAIT_V(8); PG8_WAIT_L(0); PG8_BAR; PG8_MMA2(1, At, B0, B1); PG8_BAR; PG8_SCHED;
        }
        if (wr == 0) PG8_BAR;
        E(acc, cur, wr, wc, fr, fq, lds);
        if (!has_next) break;
#pragma unroll
        for (int a = 0; a < 2; ++a)
#pragma unroll
            for (int b = 0; b < 2; ++b)
#pragma unroll
                for (int m = 0; m < 4; ++m)
#pragma unroll
                    for (int n = 0; n < 2; ++n) acc[a][b][m][n] = (f32x4){0.f, 0.f, 0.f, 0.f};
        cur = nxt; cA = nA; cB = nB; ++ui;
        if (wr == 1) PG8_BAR;
    }
    PG8_WAIT_V(0);
    PG8_BAR;
#undef PG8_SA
#undef PG8_SB
#undef PG8_STAGE
#undef PG8_LDA
#undef PG8_LDB
#undef PG8_MMA1
#undef PG8_MMA2
#undef PG8_WAIT_V
#undef PG8_WAIT_L
#undef PG8_BAR
#undef PG8_SCHED
}

struct SkF {
    bf16_t* F; float* ssm; const float* scale; int pool;
    __device__ __forceinline__ void item(int it, int& n0a, int& n0b, int& acol) const { n0a = 32 * it; n0b = n0a + 16; acol = pool ? (n0a >> 8) * 256 : 0; }
    __device__ __forceinline__ void epi(int it, int lane, f32x4 v0, f32x4 v1) const {
        const int fr = lane & 15, fq = lane >> 4, ca = 32 * it + 4 * fq, cb = ca + 16;
        v0 *= *(const f32x4*)(scale + ca); v1 *= *(const f32x4*)(scale + cb);
        u32x2 wa, wb; wa.x = cvt_pk_bf16(v0[0], v0[1]); wa.y = cvt_pk_bf16(v0[2], v0[3]); wb.x = cvt_pk_bf16(v1[0], v1[1]); wb.y = cvt_pk_bf16(v1[2], v1[3]);
        *(u32x2*)(F + (size_t)(MREAL + fr) * DM + ca) = wa; *(u32x2*)(F + (size_t)(MREAL + fr) * DM + cb) = wb;
        float ss = (v0[0] * v0[0] + v0[1] * v0[1]) + (v0[2] * v0[2] + v0[3] * v0[3]) + (v1[0] * v1[0] + v1[1] * v1[1]) + (v1[2] * v1[2] + v1[3] * v1[3]);
        ss += __shfl_xor(ss, 16); ss += __shfl_xor(ss, 32);
        if (fq == 0) ssm[fr * 32 + it] = ss;
    }
};
struct SkUp {
    bf16_t* A; const float* rstd; const float* cw; float* hg;
    __device__ __forceinline__ void item(int it, int& n0a, int& n0b, int& acol) const { n0a = (it >> 3) * 256 + (it & 7) * 16; n0b = n0a + 128; acol = 0; }
    __device__ __forceinline__ void epi(int it, int lane, f32x4 v0, f32x4 v1) const {
        const int fr = lane & 15, fq = lane >> 4, j = (it >> 3) * 128 + (it & 7) * 16 + 4 * fq;
        const float r = rstd[MREAL + fr];
        const f32x4 g = v0 * r, val = v1 * r;
        const f32x4 w0 = *(const f32x4*)(cw + j), w1 = *(const f32x4*)(cw + FF + j), w2 = *(const f32x4*)(cw + 2 * FF + j);
        f32x4 o;
#pragma unroll
        for (int e = 0; e < 4; ++e) {
            float p1 = __shfl(g[e], (lane + 63) & 63), p2 = __shfl(g[e], (lane + 62) & 63);
            p1 = fr >= 1 ? p1 : 0.f; p2 = fr >= 2 ? p2 : 0.f;
            o[e] = silu_mul(w0[e] * p2 + w1[e] * p1 + w2[e] * g[e], val[e]);
        }
        u32x2 w; w.x = cvt_pk_bf16(o[0], o[1]); w.y = cvt_pk_bf16(o[2], o[3]);
        *(u32x2*)(A + (size_t)(MREAL + fr) * FF + j) = w;
        if (fr >= 14) *(f32x4*)(hg + ((size_t)META_TILE * 2 + (fr - 14)) * FF + j) = g;
    }
};
struct SkIn {
    bf16_t* CV; bf16_t* Bb; const float* rstd;
    __device__ __forceinline__ void item(int it, int& n0a, int& n0b, int& acol) const {
        if (it < 64) { n0a = (it >> 3) * 256 + (it & 7) * 16; n0b = n0a + 128; } else { n0a = 2048 + 32 * (it - 64); n0b = n0a + 16; } acol = 0; }
    __device__ __forceinline__ void epi(int it, int lane, f32x4 v0, f32x4 v1) const {
        const int fr = lane & 15, fq = lane >> 4; const float r = rstd[MREAL + fr];
        if (it < 64) { const f32x4 cv = v0 * v1 * (r * r); u32x2 w; w.x = cvt_pk_bf16(cv[0], cv[1]); w.y = cvt_pk_bf16(cv[2], cv[3]);
            *(u32x2*)(CV + (size_t)(MREAL + fr) * DM + (it >> 3) * 128 + (it & 7) * 16 + 4 * fq) = w; }
        else { const f32x4 a = v0 * r, b = v1 * r; u32x2 wa, wb; wa.x = cvt_pk_bf16(a[0], a[1]); wa.y = cvt_pk_bf16(a[2], a[3]); wb.x = cvt_pk_bf16(b[0], b[1]); wb.y = cvt_pk_bf16(b[2], b[3]);
            const int c = 32 * (it - 64) + 4 * fq; *(u32x2*)(Bb + (size_t)(MREAL + fr) * DM + c) = wa; *(u32x2*)(Bb + (size_t)(MREAL + fr) * DM + c + 16) = wb; }
    }
};
template <int KS, class SE>
__device__ __forceinline__ void skinny_gemm(const Ctx cx, LAS unsigned char* lds, const bf16_t* A16, int lda, const bf16_t* Bt, int ldb, int nitems, const SE& E) {
    const int tid = cx.tid, wid = __builtin_amdgcn_readfirstlane(tid >> 6), lane = tid & 63, fr = lane & 15, fq = lane >> 4;
    LAS float* red = (LAS float*)lds;
    for (int it = cx.bid; it < nitems; it += cx.nblk) {
        int n0a, n0b, acol; E.item(it, n0a, n0b, acol);
        const int kofs = wid * KS * 32 + fq * 8;
        const bf16_t* ap = A16 + (size_t)fr * lda + acol + kofs;
        const bf16_t* bp0 = Bt + (size_t)(n0a + fr) * ldb + kofs;
        const bf16_t* bp1 = Bt + (size_t)(n0b + fr) * ldb + kofs;
        bf16x8 a[KS], b0[KS], b1[KS];
#pragma unroll
        for (int q = 0; q < KS; ++q) { a[q] = *(const bf16x8*)(ap + q * 32); b0[q] = *(const bf16x8*)(bp0 + q * 32); b1[q] = *(const bf16x8*)(bp1 + q * 32); }
        f32x4 c0 = (f32x4){0.f, 0.f, 0.f, 0.f}, c1 = (f32x4){0.f, 0.f, 0.f, 0.f};
#pragma unroll
        for (int q = 0; q < KS; ++q) { c0 = __builtin_amdgcn_mfma_f32_16x16x32_bf16(b0[q], a[q], c0, 0, 0, 0); c1 = __builtin_amdgcn_mfma_f32_16x16x32_bf16(b1[q], a[q], c1, 0, 0, 0); }
        *(LAS f32x4*)(red + (wid * 64 + lane) * 8) = c0; *(LAS f32x4*)(red + (wid * 64 + lane) * 8 + 4) = c1;
        __syncthreads();
        if (wid == 0) {
#pragma unroll
            for (int w = 1; w < 8; ++w) { c0 += *(LAS f32x4*)(red + (w * 64 + lane) * 8); c1 += *(LAS f32x4*)(red + (w * 64 + lane) * 8 + 4); }
            E.epi(it, lane, c0, c1);
        }
        __syncthreads();
    }
}

struct TrDesc { const float* src; const float* gain; bf16_t* dst; int ldw, ldo; };
__device__ __forceinline__ TrDesc tr_desc(const Params& p, int i) {
    bf16_t* wup = (bf16_t*)(p.ws + WS_WUP); bf16_t* wdn = (bf16_t*)(p.ws + WS_WDN); bf16_t* win = (bf16_t*)(p.ws + WS_WIN); bf16_t* wout = (bf16_t*)(p.ws + WS_WOUT); bf16_t* wp = (bf16_t*)(p.ws + WS_WP);
    constexpr int T_UP = 4 * 88 * 16, T_DN = 4 * 16 * 44, T_IN = 2 * 48 * 16, T_OUT = 2 * 16 * 16;
    TrDesc d;
    if (i < T_UP) { const int L = i / (88 * 16), r = i % (88 * 16), nb = r / 16, kb = r % 16; const int n0 = nb * 64, chunk = n0 >> 7, pn = chunk >> 1, h = chunk & 1;
        d.ldw = 2 * FF; d.ldo = DM; d.src = p.ffn_w_up + (size_t)L * DM * 2 * FF + (size_t)(kb * 64) * d.ldw + h * FF + pn * 128 + (n0 & 127);
        d.gain = p.norm_g + (L * 4 + 2) * DM + kb * 64; d.dst = wup + (size_t)L * 5632 * DM + (size_t)n0 * DM + kb * 64; return d; }
    i -= T_UP;
    if (i < T_DN) { const int L = i / (16 * 44), r = i % (16 * 44), nb = r / 44, kb = r % 44;
        d.ldw = DM; d.ldo = FF; d.src = p.ffn_w_down + (size_t)L * FF * DM + (size_t)(kb * 64) * DM + nb * 64; d.gain = nullptr; d.dst = wdn + (size_t)L * DM * FF + (size_t)(nb * 64) * FF + kb * 64; return d; }
    i -= T_DN;
    if (i < T_IN) { const int j = i / (48 * 16), r = i % (48 * 16), nb = r / 16, kb = r % 16; const int n0 = nb * 64, chunk = n0 >> 7;
        const int c0 = (chunk < 16) ? (DM * (1 + (chunk & 1)) + (chunk >> 1) * 128 + (n0 & 127)) : ((chunk - 16) * 128 + (n0 & 127));
        d.ldw = 3 * DM; d.ldo = DM; d.src = p.sc_w_in + (size_t)j * DM * 3 * DM + (size_t)(kb * 64) * d.ldw + c0; d.gain = p.norm_g + ((2 * j + 1) * 4 + 0) * DM + kb * 64;
        d.dst = win + (size_t)j * 3072 * DM + (size_t)n0 * DM + kb * 64; return d; }
    i -= T_IN;
    if (i < T_OUT) { const int j = i / 256, r = i % 256, nb = r / 16, kb = r % 16;
        d.ldw = DM; d.ldo = DM; d.src = p.sc_w_out + (size_t)j * DM * DM + (size_t)(kb * 64) * DM + nb * 64; d.gain = nullptr; d.dst = wout + (size_t)j * DM * DM + (size_t)(nb * 64) * DM + kb * 64; return d; }
    i -= T_OUT;
    { const int j = i / 64, r = i % 64, gI = r / 16, nb = (r % 16) / 4, kb = r % 4;
        d.ldw = 256; d.ldo = 256; d.src = p.pool_w + ((size_t)j * 4 + gI) * 256 * 256 + (size_t)(kb * 64) * 256 + nb * 64; d.gain = p.norm_g + ((2 * j) * 4 + 0) * DM + gI * 256 + kb * 64;
        d.dst = wp + ((size_t)j * 1024 + gI * 256 + nb * 64) * 256 + kb * 64; return d; }
}
__device__ __forceinline__ void tr_load(const TrDesc& d, int tx, int ty, float (&v)[8]) {
#pragma unroll
    for (int q = 0; q < 8; ++q) { const int kk = ty + 8 * q; float x = d.src[(size_t)kk * d.ldw + tx]; if (d.gain) x *= d.gain[kk]; v[q] = x; }
}
__device__ void phase_prologue(const Ctx cx, const Params& p, LAS unsigned char* lds) {
    LAS float* t = (LAS float*)lds;
    constexpr int T_ALL = 4 * 88 * 16 + 4 * 16 * 44 + 2 * 48 * 16 + 2 * 16 * 16;
    const int tid = cx.tid, tx = tid & 63, ty = tid >> 6, wid = tid >> 6, lane = tid & 63;
    {
        int it = cx.bid; float v[8]; TrDesc d = tr_desc(p, it < T_ALL ? it : 0);
        if (it < T_ALL) tr_load(d, tx, ty, v);
        while (it < T_ALL) {
#pragma unroll
            for (int q = 0; q < 8; ++q) t[(ty + 8 * q) * 65 + tx] = v[q];
            lds_barrier();
            const int itn = it + cx.nblk; TrDesc dn = d;
            if (itn < T_ALL) { dn = tr_desc(p, itn); tr_load(dn, tx, ty, v); }
            const int n = tid >> 3, ks = tid & 7; float o[8];
#pragma unroll
            for (int i = 0; i < 8; ++i) o[i] = t[(ks * 8 + i) * 65 + n];
            u32x4 w; w.x = cvt_pk_bf16(o[0], o[1]); w.y = cvt_pk_bf16(o[2], o[3]); w.z = cvt_pk_bf16(o[4], o[5]); w.w = cvt_pk_bf16(o[6], o[7]);
            *(u32x4*)(d.dst + (size_t)n * d.ldo + ks * 8) = w;
            lds_barrier();
            it = itn; d = dn;
        }
    }
    bf16_t* Hb = (bf16_t*)(p.ws + WS_HB); float* rstd = (float*)(p.ws + WS_RSTD);
    const int stride = cx.nblk * 8;
    for (int row = cx.bid * 8 + wid; row < NVROWS; row += 2 * stride) {
        f32x4 v[2][4];
#pragma unroll
        for (int h = 0; h < 2; ++h) { const int rw = row + h * stride; const int m = rw - MREAL;
            const float* src = rw < MREAL ? p.x + (size_t)rw * DM : ((m < NMETA) ? p.meta + (size_t)m * DM : nullptr);
#pragma unroll
            for (int c = 0; c < 4; ++c) v[h][c] = (src && rw < NVROWS) ? *(const f32x4*)(src + c * 256 + lane * 4) : (f32x4){0.f, 0.f, 0.f, 0.f}; }
#pragma unroll
        for (int h = 0; h < 2; ++h) { const int rw = row + h * stride; if (rw >= NVROWS) break;
            float ss = 0.f;
#pragma unroll
            for (int c = 0; c < 4; ++c) { const int col = c * 256 + lane * 4; const f32x4 x = v[h][c];
                u32x2 w; w.x = cvt_pk_bf16(x[0], x[1]); w.y = cvt_pk_bf16(x[2], x[3]); *(u32x2*)(Hb + (size_t)rw * DM + col) = w;
                const float q0 = bf_lo(w.x), q1 = bf_hi(w.x), q2 = bf_lo(w.y), q3 = bf_hi(w.y); ss += (q0 * q0 + q1 * q1) + (q2 * q2 + q3 * q3); }
            ss = wave_sum(ss);
            if (lane == 0) rstd[rw] = 1.0f / sqrtf(ss * (1.0f / DM) + RMS_EPS); }
    }
    if (cx.bid == 0) { float* ones = (float*)(p.ws + WS_ONES); for (int i = cx.tid; i < DM; i += 512) ones[i] = 1.0f; }
    {
        bf16_t* wp = (bf16_t*)(p.ws + WS_WP);
        for (int f = cx.bid * 512 + cx.tid; f < 2 * 8 * 8 * 8 * 64; f += cx.nblk * 512) {
            const int ln = f & 63, ks = (f >> 6) & 7, nb = (f >> 9) & 7, wv = (f >> 12) & 7, j = f >> 15, fr = ln & 15, fq = ln >> 4;
            const int row = 128 * wv + 32 * (nb >> 1) + perm32(16 * (nb & 1) + fr), gI = row >> 8, nn = row & 255, k0 = 32 * ks + 8 * fq;
            const float* src = p.pool_w + (((size_t)j * 4 + gI) * 256 + k0) * 256 + nn; const float* gn = p.norm_g + ((2 * j) * 4 + 0) * DM + gI * 256 + k0;
            float v[8];
#pragma unroll
            for (int i = 0; i < 8; ++i) v[i] = src[(size_t)i * 256] * gn[i];
            u32x4 o; o.x = cvt_pk_bf16(v[0], v[1]); o.y = cvt_pk_bf16(v[2], v[3]); o.z = cvt_pk_bf16(v[4], v[5]); o.w = cvt_pk_bf16(v[6], v[7]);
            *(u32x4*)(wp + (size_t)f * 8) = o;
        }
    }
}

__device__ void phase_eres(const Ctx cx, const Params& p, bf16_t* Hb, float* rstd, const float* g, bool last) {
    const int wid = cx.tid >> 6, lane = cx.tid & 63;
    const bf16_t* F = (const bf16_t*)(p.ws + WS_F); const float* ssp = (const float*)(p.ws + WS_SSF);
    const int nrows = last ? MREAL : NVROWS; const float* ssm = (const float*)(p.ws + WS_SSM);
    f32x4 gv[2][2];
#pragma unroll
    for (int c = 0; c < 2; ++c) { gv[c][0] = *(const f32x4*)(g + c * 512 + lane * 8); gv[c][1] = *(const f32x4*)(g + c * 512 + lane * 8 + 4); }
    const int stride = cx.nblk * 8;
    for (int row = cx.bid * 8 + wid; row < nrows; row += 2 * stride) {
        u32x4 hw[2][2], fw[2][2]; float sp[2];
#pragma unroll
        for (int h = 0; h < 2; ++h) { int rw = row + h * stride; rw = rw < nrows ? rw : row;
            sp[h] = rw < MREAL ? (lane < 16 ? ssp[(size_t)rw * 16 + lane] : 0.f) : (lane < 32 ? ssm[(rw - MREAL) * 32 + lane] : 0.f);
#pragma unroll
            for (int c = 0; c < 2; ++c) { const int col = c * 512 + lane * 8; hw[h][c] = *(const u32x4*)(Hb + (size_t)rw * DM + col); fw[h][c] = *(const u32x4*)(F + (size_t)rw * DM + col); } }
#pragma unroll
        for (int h = 0; h < 2; ++h) { const int rw = row + h * stride; if (rw >= nrows) break;
            const float s = wave_sum(sp[h]);
            const float rf = 1.0f / sqrtf(s * (1.0f / DM) + RMS_EPS);
            float ss = 0.f;
#pragma unroll
            for (int c = 0; c < 2; ++c) { const int col = c * 512 + lane * 8; const u32x4 hq = hw[h][c], f = fw[h][c]; f32x4 va, vb;
                va[0] = bf_lo(hq.x) + bf_lo(f.x) * rf * gv[c][0][0]; va[1] = bf_hi(hq.x) + bf_hi(f.x) * rf * gv[c][0][1]; va[2] = bf_lo(hq.y) + bf_lo(f.y) * rf * gv[c][0][2]; va[3] = bf_hi(hq.y) + bf_hi(f.y) * rf * gv[c][0][3];
                vb[0] = bf_lo(hq.z) + bf_lo(f.z) * rf * gv[c][1][0]; vb[1] = bf_hi(hq.z) + bf_hi(f.z) * rf * gv[c][1][1]; vb[2] = bf_lo(hq.w) + bf_lo(f.w) * rf * gv[c][1][2]; vb[3] = bf_hi(hq.w) + bf_hi(f.w) * rf * gv[c][1][3];
                if (last) { float* op = p.out + (size_t)rw * DM + col; *(f32x4*)op = va; *(f32x4*)(op + 4) = vb; }
                else { u32x4 w; w.x = cvt_pk_bf16(va[0], va[1]); w.y = cvt_pk_bf16(va[2], va[3]); w.z = cvt_pk_bf16(vb[0], vb[1]); w.w = cvt_pk_bf16(vb[2], vb[3]);
                    *(u32x4*)(Hb + (size_t)rw * DM + col) = w;
#pragma unroll
                    for (int e = 0; e < 4; ++e) { const float q0 = bf_lo(w[e]), q1 = bf_hi(w[e]); ss += q0 * q0 + q1 * q1; } } }
            if (!last) { ss = wave_sum(ss); if (lane == 0) rstd[rw] = 1.0f / sqrtf(ss * (1.0f / DM) + RMS_EPS); } }
    }
}
template <int W>
__device__ __forceinline__ void pool_task(const bf16_t* __restrict__ Hb, const float* __restrict__ rstd, bf16_t* __restrict__ P, int row0, int c0) {
    u32x2 raw[W + 15]; float rs[W + 15];
#pragma unroll
    for (int i = 0; i < W + 15; ++i) {
        const int off = i - (W - 1);
        int r = (off >= 0) ? row0 + off : prev_row(row0, -off);
        const bool valid = r >= 0; r = valid ? r : row0;
        raw[i] = *(const u32x2*)(Hb + (size_t)r * DM + c0); rs[i] = valid ? rstd[r] : 0.f;
    }
    const bool meta = row0 >= MREAL;
    float S[4] = {0.f, 0.f, 0.f, 0.f};
#pragma unroll
    for (int i = 0; i < W - 1; ++i) { S[0] += bf_lo(raw[i].x) * rs[i]; S[1] += bf_hi(raw[i].x) * rs[i]; S[2] += bf_lo(raw[i].y) * rs[i]; S[3] += bf_hi(raw[i].y) * rs[i]; }
#pragma unroll
    for (int o = 0; o < 16; ++o) {
        const int i = o + W - 1;
        const float u0 = bf_lo(raw[i].x) * rs[i], u1 = bf_hi(raw[i].x) * rs[i], u2 = bf_lo(raw[i].y) * rs[i], u3 = bf_hi(raw[i].y) * rs[i];
        S[0] += u0; S[1] += u1; S[2] += u2; S[3] += u3;
        const float inv = meta ? 1.0f / (float)((o + 1) < W ? (o + 1) : W) : 1.0f / (float)W;
        u32x2 w; w.x = cvt_pk_bf16(S[0] * inv - u0, S[1] * inv - u1); w.y = cvt_pk_bf16(S[2] * inv - u2, S[3] * inv - u3);
        *(u32x2*)(P + (size_t)(row0 + o) * DM + c0) = w;
        S[0] -= bf_lo(raw[o].x) * rs[o]; S[1] -= bf_hi(raw[o].x) * rs[o]; S[2] -= bf_lo(raw[o].y) * rs[o]; S[3] -= bf_hi(raw[o].y) * rs[o];
    }
}
__device__ void phase_epool(const Ctx cx, const Params& p) {
    const bf16_t* Hb = (const bf16_t*)(p.ws + WS_HB); const float* rstd = (const float*)(p.ws + WS_RSTD); bf16_t* P = (bf16_t*)(p.ws + WS_ACT);
    const int wid = __builtin_amdgcn_readfirstlane(cx.tid >> 6), lane = cx.tid & 63;
    constexpr int NTASK = (MREAL / 16 + 1) * 4;
    for (int task = cx.bid * 8 + wid; task < NTASK; task += cx.nblk * 8) {
        const int chunk = task >> 2, gI = task & 3, row0 = chunk * 16, c0 = gI * 256 + lane * 4;
        if (gI == 0) pool_task<2>(Hb, rstd, P, row0, c0); else if (gI == 1) pool_task<4>(Hb, rstd, P, row0, c0); else if (gI == 2) pool_task<8>(Hb, rstd, P, row0, c0); else pool_task<16>(Hb, rstd, P, row0, c0);
    }
}
template <int W>
__device__ __forceinline__ void pool_task_lds(const bf16_t* __restrict__ Hb, const float* __restrict__ rstd, LAS unsigned char* ldsA, int row0, int lrow0, int c0) {
    u32x2 raw[W + 15]; float rs[W + 15];
#pragma unroll
    for (int i = 0; i < W + 15; ++i) {
        const int off = i - (W - 1);
        int r = (off >= 0) ? row0 + off : prev_row(row0, -off);
        const bool valid = r >= 0; r = valid ? r : row0;
        raw[i] = *(const u32x2*)(Hb + (size_t)r * DM + c0); rs[i] = valid ? rstd[r] : 0.f;
    }
    const bool meta = row0 >= MREAL;
    float S[4] = {0.f, 0.f, 0.f, 0.f};
#pragma unroll
    for (int i = 0; i < W - 1; ++i) { S[0] += bf_lo(raw[i].x) * rs[i]; S[1] += bf_hi(raw[i].x) * rs[i]; S[2] += bf_lo(raw[i].y) * rs[i]; S[3] += bf_hi(raw[i].y) * rs[i]; }
#pragma unroll
    for (int o = 0; o < 16; ++o) {
        const int i = o + W - 1;
        const float u0 = bf_lo(raw[i].x) * rs[i], u1 = bf_hi(raw[i].x) * rs[i], u2 = bf_lo(raw[i].y) * rs[i], u3 = bf_hi(raw[i].y) * rs[i];
        S[0] += u0; S[1] += u1; S[2] += u2; S[3] += u3;
        const float inv = meta ? 1.0f / (float)((o + 1) < W ? (o + 1) : W) : 1.0f / (float)W;
        u32x2 w; w.x = cvt_pk_bf16(S[0] * inv - u0, S[1] * inv - u1); w.y = cvt_pk_bf16(S[2] * inv - u2, S[3] * inv - u3);
        *(LAS u32x2*)(ldsA + (lrow0 + o) * PA_STRIDE_B + c0 * 2) = w;
        S[0] -= bf_lo(raw[o].x) * rs[o]; S[1] -= bf_hi(raw[o].x) * rs[o]; S[2] -= bf_lo(raw[o].y) * rs[o]; S[3] -= bf_hi(raw[o].y) * rs[o];
    }
}
__device__ void phase_poolmix(const Ctx cx, LAS unsigned char* lds, const bf16_t* Hin, const float* rstd_in, bf16_t* Hout, float* rstd_out,
                              const bf16_t* Wp  , const float* scale, const float* g1) {
    const int tid = cx.tid, w = __builtin_amdgcn_readfirstlane(tid >> 6), lane = tid & 63, fr = lane & 15, fq = lane >> 4;
    LAS float* red1 = (LAS float*)(lds + PM_RED_OFF); LAS float* red2 = red1 + 64 * 8;
    constexpr int NU = MREAL / 64 + 1;
    for (int unit = cx.bid; unit < NU; unit += cx.nblk) {
        const int row0 = unit * 64; const int nm = (unit == NU - 1) ? 1 : 4;
        for (int task = w; task < 4 * nm; task += 8) {
            const int chunk = task >> 2, gI = task & 3, c0 = gI * 256 + lane * 4, r0 = row0 + chunk * 16, l0 = chunk * 16;
            if (gI == 0) pool_task_lds<2>(Hin, rstd_in, lds, r0, l0, c0); else if (gI == 1) pool_task_lds<4>(Hin, rstd_in, lds, r0, l0, c0);
            else if (gI == 2) pool_task_lds<8>(Hin, rstd_in, lds, r0, l0, c0); else pool_task_lds<16>(Hin, rstd_in, lds, r0, l0, c0);
        }
        __syncthreads();
        f32x4 acc[4][8];
#pragma unroll
        for (int m = 0; m < 4; ++m)
#pragma unroll
            for (int nb = 0; nb < 8; ++nb) acc[m][nb] = (f32x4){0.f, 0.f, 0.f, 0.f};
        const int kA = (w >> 1) * 256 + fq * 8;
        unsigned long long bbi = (unsigned long long)(Wp + ((size_t)w * 64 * 64 + lane) * 8); asm volatile("" : "+v"(bbi));
        const __attribute__((address_space(1))) bf16x8* bb = (const __attribute__((address_space(1))) bf16x8*)bbi;
#define PMX_B(nb, ks) (bb[((nb) * 8 + (ks)) * 64])
        bf16x8 bc[8], bn[8];
#pragma unroll
        for (int nb = 0; nb < 8; ++nb) bc[nb] = PMX_B(nb, 0);
#pragma unroll
        for (int ks = 0; ks < 8; ++ks) {
            if (ks < 7) {
#pragma unroll
                for (int nb = 0; nb < 8; ++nb) bn[nb] = PMX_B(nb, ks + 1);
            }
#pragma unroll
            for (int m = 0; m < 4; ++m) if (m < nm) {
                const bf16x8 a = *(const LAS bf16x8*)(lds + (m * 16 + fr) * PA_STRIDE_B + (kA + ks * 32) * 2);
#pragma unroll
                for (int nb = 0; nb < 8; ++nb) acc[m][nb] = __builtin_amdgcn_mfma_f32_16x16x32_bf16(bc[nb], a, acc[m][nb], 0, 0, 0);
            }
#pragma unroll
            for (int nb = 0; nb < 8; ++nb) bc[nb] = bn[nb];
        }
#undef PMX_B
#pragma unroll
        for (int cg = 0; cg < 4; ++cg) {
            const int c8 = 128 * w + 32 * cg + 8 * fq;
            const f32x4 s0 = *(const f32x4*)(scale + c8), s1 = *(const f32x4*)(scale + c8 + 4);
#pragma unroll
            for (int m = 0; m < 4; ++m) { acc[m][2 * cg] *= s0; acc[m][2 * cg + 1] *= s1; }
        }
#pragma unroll
        for (int m = 0; m < 4; ++m) {
            float ssq = 0.f;
#pragma unroll
            for (int nb = 0; nb < 8; ++nb) { const f32x4 v = acc[m][nb]; ssq += (v[0] * v[0] + v[1] * v[1]) + (v[2] * v[2] + v[3] * v[3]); }
            ssq += __shfl_xor(ssq, 16); ssq += __shfl_xor(ssq, 32);
            if (fq == 0) red1[(m * 16 + fr) * 8 + w] = ssq;
        }
        __syncthreads();
        float rf[4];
#pragma unroll
        for (int m = 0; m < 4; ++m) { const f32x4 x0 = *(LAS f32x4*)(red1 + (m * 16 + fr) * 8), x1 = *(LAS f32x4*)(red1 + (m * 16 + fr) * 8 + 4);
            rf[m] = 1.0f / sqrtf(((x0[0] + x0[1]) + (x0[2] + x0[3]) + (x1[0] + x1[1]) + (x1[2] + x1[3])) * (1.0f / DM) + RMS_EPS); }
        float s2[4] = {0.f, 0.f, 0.f, 0.f};
#pragma unroll
        for (int cg = 0; cg < 4; ++cg) {
            const int c8 = 128 * w + 32 * cg + 8 * fq;
            const f32x4 g0 = *(const f32x4*)(g1 + c8), g4 = *(const f32x4*)(g1 + c8 + 4);
#pragma unroll
            for (int m = 0; m < 4; ++m) if (m < nm) {
                const size_t off = (size_t)(row0 + m * 16 + fr) * DM + c8;
                const u32x4 ho = *(const u32x4*)(Hin + off);
                const f32x4 va = acc[m][2 * cg] * rf[m] * g0, vb = acc[m][2 * cg + 1] * rf[m] * g4;
                u32x4 o;
                o.x = cvt_pk_bf16(bf_lo(ho.x) + va[0], bf_hi(ho.x) + va[1]); o.y = cvt_pk_bf16(bf_lo(ho.y) + va[2], bf_hi(ho.y) + va[3]);
                o.z = cvt_pk_bf16(bf_lo(ho.z) + vb[0], bf_hi(ho.z) + vb[1]); o.w = cvt_pk_bf16(bf_lo(ho.w) + vb[2], bf_hi(ho.w) + vb[3]);
                *(u32x4*)(Hout + off) = o;
#pragma unroll
                for (int e = 0; e < 4; ++e) { const float q0 = bf_lo(o[e]), q1 = bf_hi(o[e]); s2[m] += q0 * q0 + q1 * q1; }
            }
        }
#pragma unroll
        for (int m = 0; m < 4; ++m) { float t = s2[m]; t += __shfl_xor(t, 16); t += __shfl_xor(t, 32); if (fq == 0) red2[(m * 16 + fr) * 8 + w] = t; }
        lds_barrier();
        if (tid < 16 * nm) { const f32x4 x0 = *(LAS f32x4*)(red2 + tid * 8), x1 = *(LAS f32x4*)(red2 + tid * 8 + 4);
            rstd_out[row0 + tid] = 1.0f / sqrtf(((x0[0] + x0[1]) + (x0[2] + x0[3]) + (x1[0] + x1[1]) + (x1[2] + x1[3])) * (1.0f / DM) + RMS_EPS); }
        lds_barrier();
    }
}
__device__ void phase_econv(const Ctx cx, const Params& p, const float* cw) {
    const bf16_t* CV = (const bf16_t*)(p.ws + WS_ACT); const bf16_t* Bb = CV + (size_t)MROWS * DM; bf16_t* Y = (bf16_t*)(p.ws + WS_ACT) + (size_t)2 * MROWS * DM;
    const int tid = cx.tid, sub = tid >> 7, c0 = (tid & 127) * 8;
    float w0[8], w1[8], w2[8];
#pragma unroll
    for (int e = 0; e < 8; ++e) { w0[e] = cw[c0 + e]; w1[e] = cw[DM + c0 + e]; w2[e] = cw[2 * DM + c0 + e]; }
    constexpr int NCH = (MREAL + 16) / 4;
    for (int ch = cx.bid * 4 + sub; ch < NCH; ch += cx.nblk * 4) {
        const int row0 = ch * 4; const int r1 = prev_row(row0, 1), r2 = prev_row(row0, 2);
        const u32x4 z = (u32x4){0u, 0u, 0u, 0u};
        u32x4 x[6], bb[4];
        x[0] = r2 >= 0 ? *(const u32x4*)(CV + (size_t)r2 * DM + c0) : z;
        x[1] = r1 >= 0 ? *(const u32x4*)(CV + (size_t)r1 * DM + c0) : z;
#pragma unroll
        for (int i = 0; i < 4; ++i) { x[2 + i] = *(const u32x4*)(CV + (size_t)(row0 + i) * DM + c0); bb[i] = *(const u32x4*)(Bb + (size_t)(row0 + i) * DM + c0); }
#pragma unroll
        for (int i = 0; i < 4; ++i) {
            float y[8];
#pragma unroll
            for (int e = 0; e < 4; ++e) {
                y[2 * e] = bf_lo(bb[i][e]) * (w0[2 * e] * bf_lo(x[i][e]) + w1[2 * e] * bf_lo(x[i + 1][e]) + w2[2 * e] * bf_lo(x[i + 2][e]));
                y[2 * e + 1] = bf_hi(bb[i][e]) * (w0[2 * e + 1] * bf_hi(x[i][e]) + w1[2 * e + 1] * bf_hi(x[i + 1][e]) + w2[2 * e + 1] * bf_hi(x[i + 2][e]));
            }
            u32x4 o; o.x = cvt_pk_bf16(y[0], y[1]); o.y = cvt_pk_bf16(y[2], y[3]); o.z = cvt_pk_bf16(y[4], y[5]); o.w = cvt_pk_bf16(y[6], y[7]);
            *(u32x4*)(Y + (size_t)(row0 + i) * DM + c0) = o;
        }
    }
}
__device__ void fixup_rows(const Ctx cx, const Params& p, const StaticOrder& S, const float* cw) {
    bf16_t* A = (bf16_t*)(p.ws + WS_ACT); const float* hg = (const float*)(p.ws + WS_HG); const float* hr = (const float*)(p.ws + WS_HR);
    int nun = 0; { Unit u; while (S.next(nun, u)) ++nun; }
    constexpr int NQ = FF / 4;
    for (int t = cx.tid; t < nun * NQ; t += 512) {
        Unit u; S.next(t / NQ, u);
        const int pm = u.pm, j = (t % NQ) * 4;
        const float* src = ((pm & 7) == 0) ? hg + (size_t)META_TILE * 2 * FF : hg + (size_t)(pm - 1) * 2 * FF;
        const f32x4 gm2 = *(const f32x4*)(src + j), gm1 = *(const f32x4*)(src + FF + j);
        const float* h0 = hr + ((size_t)pm * 2 + 0) * 2 * FF + j; const float* h1 = hr + ((size_t)pm * 2 + 1) * 2 * FF + j;
        const f32x4 g0 = *(const f32x4*)h0, v0 = *(const f32x4*)(h0 + FF), g1 = *(const f32x4*)h1, v1 = *(const f32x4*)(h1 + FF);
        const f32x4 k0 = *(const f32x4*)(cw + j), k1 = *(const f32x4*)(cw + FF + j), k2 = *(const f32x4*)(cw + 2 * FF + j);
        const f32x4 c0 = k0 * gm2 + k1 * gm1 + k2 * g0, c1 = k0 * gm1 + k1 * g0 + k2 * g1;
        u32x2 o0, o1;
        o0.x = cvt_pk_bf16(silu_mul(c0[0], v0[0]), silu_mul(c0[1], v0[1])); o0.y = cvt_pk_bf16(silu_mul(c0[2], v0[2]), silu_mul(c0[3], v0[3]));
        o1.x = cvt_pk_bf16(silu_mul(c1[0], v1[0]), silu_mul(c1[1], v1[1])); o1.y = cvt_pk_bf16(silu_mul(c1[2], v1[2]), silu_mul(c1[3], v1[3]));
        *(u32x2*)(A + (size_t)(pm * BM) * FF + j) = o0; *(u32x2*)(A + (size_t)(pm * BM + 1) * FF + j) = o1;
    }
    asm volatile("s_waitcnt vmcnt(0)" ::: "memory");
    __syncthreads();
}

enum { K_PRO = 0, K_POOLMIX, K_GPOOL_UNUSED, K_ERES0, K_GUP, K_GDOWN, K_ERES1, K_GIN, K_ECONV, K_GOUT };
constexpr int N_PHASES = 23;
__device__ __forceinline__ void decode_phase(int ph, int& layer, int& kind) {
    if (ph == 0) { layer = 0; kind = K_PRO; return; }
    const int q = ph - 1, pair = q / 11, r = q % 11;
    if (r < 4) { layer = 2 * pair; kind = (r == 0) ? K_POOLMIX : (r == 1) ? K_GUP : (r == 2) ? K_GDOWN : K_ERES1; }
    else { const int s = r - 4; layer = 2 * pair + 1; kind = (s == 0) ? K_GIN : (s == 1) ? K_ECONV : (s == 2) ? K_GOUT : (s == 3) ? K_ERES0 : (s == 4) ? K_GUP : (s == 5) ? K_GDOWN : K_ERES1; }
}

__global__ void __launch_bounds__(512, 2) mk_fwd(Params p_in) {
    extern __shared__ __attribute__((aligned(16))) unsigned char shm[];
    LAS unsigned char* lds = (LAS unsigned char*)shm;
    cg::grid_group grid = cg::this_grid();
    typedef const Params __attribute__((address_space(4)))* KArgPtr;
    const int ph_hi = p_in.ph_hi, coop = p_in.coop;
    XcdBarrier xb; xb.bar = (unsigned*)(p_in.ws + WS_BAR); xb.x = 0; xb.st = (volatile LAS unsigned*)(lds + XBST_OFF);
    if (coop) {
        if (threadIdx.x == 0) { xb.st[0] = 0u; xb.st[1] = 0u; }
        __syncthreads();
        xb.x = xb_xcc_id();
        if (threadIdx.x == 0) (void)xb_add(&xb.bar[XB_XCNT(xb.x)], 1u);
    }
#ifndef PROBE_REPEAT_MASK
#define PROBE_REPEAT_MASK 0
#endif
    for (int ph2 = p_in.ph_lo * 2; ph2 < ph_hi * 2; ++ph2) {
        const int ph = ph2 >> 1;
        int layer, kind; decode_phase(ph, layer, kind);
        if ((ph2 & 1) && !((PROBE_REPEAT_MASK >> kind) & 1)) continue;
        KArgPtr kp = (KArgPtr)__builtin_amdgcn_kernarg_segment_ptr();
        asm volatile("" : "+s"(layer), "+s"(kind), "+s"(kp));
        Params p;
        p.x = kp->x; p.meta = kp->meta; p.pool_w = kp->pool_w; p.pool_scale = kp->pool_scale; p.sc_w_in = kp->sc_w_in; p.sc_conv = kp->sc_conv; p.sc_w_out = kp->sc_w_out;
        p.ffn_w_up = kp->ffn_w_up; p.ffn_conv = kp->ffn_conv; p.ffn_w_down = kp->ffn_w_down; p.norm_g = kp->norm_g; p.out = kp->out; p.ws = kp->ws;
        p.ph_lo = 0; p.ph_hi = 0; p.coop = 0; p.pad = 0;
        unsigned char* wsb = p.ws;
        Ctx cx; cx.tid = threadIdx.x; cx.bid = blockIdx.x; cx.nblk = gridDim.x;
        asm volatile("" : "+v"(cx.tid), "+s"(cx.bid), "+s"(cx.nblk));
#ifdef ONLY_KIND
        kind = ONLY_KIND;
#endif
        const int sidx = layer * 2 + ((kind == K_GUP || kind == K_GDOWN || kind == K_ERES1) ? 1 : 0);
        const bool useB = (sidx >= 1 && sidx <= 4);
        bf16_t* Hb = (bf16_t*)(wsb + (useB ? WS_HB2 : WS_HB)); float* rstd = (float*)(wsb + (useB ? WS_RSTD2 : WS_RSTD));
        bf16_t* F = (bf16_t*)(wsb + WS_F); bf16_t* ACT = (bf16_t*)(wsb + WS_ACT);
        float* ssp = (float*)(wsb + WS_SSF); const float* ones = (const float*)(wsb + WS_ONES);
        const int j = layer >> 1;
        StaticOrder S;
        switch (kind) {
        case K_PRO: phase_prologue(cx, p, lds); break;
        case K_POOLMIX: {
            bf16_t* Ho = (bf16_t*)(wsb + (useB ? WS_HB : WS_HB2)); float* ro = (float*)(wsb + (useB ? WS_RSTD : WS_RSTD2));
            phase_poolmix(cx, lds, Hb, rstd, Ho, ro, (const bf16_t*)(wsb + WS_WP) + (size_t)j * 1024 * 256, p.pool_scale + (size_t)j * DM, p.norm_g + (layer * 4 + 1) * DM);
        } break;
        case K_ECONV: phase_econv(cx, p, p.sc_conv + (size_t)j * 3 * DM); break;
        case K_ERES0: phase_eres(cx, p, Hb, rstd, p.norm_g + (layer * 4 + 1) * DM, false); break;
        case K_ERES1: phase_eres(cx, p, Hb, rstd, p.norm_g + (layer * 4 + 3) * DM, layer == 3); break;
        case K_GDOWN: case K_GOUT: {
            Gemm g; EpiF E; E.F = F; E.ssp = ssp; E.scale = ones; SkF SE; SE.F = F; SE.ssm = (float*)(wsb + WS_SSM); SE.scale = ones; SE.pool = 0;
            if (kind == K_GDOWN) g = Gemm{ACT, (const bf16_t*)(wsb + WS_WDN) + (size_t)layer * DM * FF, MREAL, DM, FF, FF, FF, 0};
            else g = Gemm{ACT + (size_t)2 * MROWS * DM, (const bf16_t*)(wsb + WS_WOUT) + (size_t)j * DM * DM, MREAL, DM, DM, DM, DM, 0};
            S.init(g.M, g.N, cx.nblk, cx.bid);
            if (kind == K_GDOWN) fixup_rows(cx, p, S, p.ffn_conv + (size_t)layer * 3 * FF);
            gemm_phase<EpiF>(cx, lds, g, S, E);
            const bf16_t* A16 = g.A + (size_t)MREAL * g.lda;
            if (kind == K_GDOWN) skinny_gemm<11, SkF>(cx, lds, A16, g.lda, g.Bt, g.ldb, 32, SE);
            else skinny_gemm<4, SkF>(cx, lds, A16, g.lda, g.Bt, g.ldb, 32, SE);
        } break;
        case K_GUP: {
            Gemm g{Hb, (const bf16_t*)(wsb + WS_WUP) + (size_t)layer * 5632 * DM, MREAL, 5632, DM, DM, DM, 0};
            EpiUp E{ACT, rstd, p.ffn_conv + (size_t)layer * 3 * FF, (float*)(wsb + WS_HG), (float*)(wsb + WS_HR)};
            S.init(g.M, g.N, cx.nblk, cx.bid);
            gemm_phase<EpiUp>(cx, lds, g, S, E);
            SkUp SE{ACT, rstd, p.ffn_conv + (size_t)layer * 3 * FF, (float*)(wsb + WS_HG)};
            skinny_gemm<4, SkUp>(cx, lds, Hb + (size_t)MREAL * DM, DM, g.Bt, DM, 176, SE);
        } break;
        case K_GIN: {
            Gemm g{Hb, (const bf16_t*)(wsb + WS_WIN) + (size_t)j * 3072 * DM, MREAL, 3072, DM, DM, DM, 0};
            EpiIn E{ACT, ACT + (size_t)MROWS * DM, rstd};
            S.init(g.M, g.N, cx.nblk, cx.bid);
            gemm_phase<EpiIn>(cx, lds, g, S, E);
            SkIn SE{ACT, ACT + (size_t)MROWS * DM, rstd};
            skinny_gemm<4, SkIn>(cx, lds, Hb + (size_t)MREAL * DM, DM, g.Bt, DM, 96, SE);
        } break;
        }
        if (ph2 + 1 < ph_hi * 2 && (!(ph2 & 1) ? (((PROBE_REPEAT_MASK >> kind) & 1) || ph + 1 < ph_hi) : (ph + 1 < ph_hi))) { if (coop == 2) grid.sync(); else if (coop) xcd_barrier(xb, cx.tid, (unsigned)cx.nblk); }
    }
}

extern "C" void kernel_launch(void* const* d_in, const int* in_sizes, int n_in, void* d_out, int out_size, void* d_ws, size_t ws_size, hipStream_t stream) {
    static int grid = 0;
    if (grid == 0) {
        if (n_in != 11 || out_size != MREAL * DM || ws_size < WS_END) { fprintf(stderr, "kernel_launch: unexpected shapes (n_in %d out %d ws %zu need %zu)\n", n_in, out_size, ws_size, (size_t)WS_END); grid = -1; return; }
        int dev = 0, cus = 0, per_cu = 0;
        hipGetDevice(&dev); hipDeviceGetAttribute(&cus, hipDeviceAttributeMultiprocessorCount, dev);
        if (hipFuncSetAttribute((const void*)mk_fwd, hipFuncAttributeMaxDynamicSharedMemorySize, LDS_BYTES) != hipSuccess) { fprintf(stderr, "kernel_launch: hipFuncSetAttribute failed\n"); grid = -1; return; }
        if (hipOccupancyMaxActiveBlocksPerMultiprocessor(&per_cu, (const void*)mk_fwd, 512, LDS_BYTES) != hipSuccess || per_cu < 1) { fprintf(stderr, "kernel_launch: occupancy query says %d\n", per_cu); per_cu = 1; }
        (void)hipGetLastError();
        grid = cus * 1;
    }
    if (grid < 0) return;
    Params p{};
    p.x = (const float*)d_in[0]; p.meta = (const float*)d_in[1]; p.pool_w = (const float*)d_in[2]; p.pool_scale = (const float*)d_in[3]; p.sc_w_in = (const float*)d_in[4];
    p.sc_conv = (const float*)d_in[5]; p.sc_w_out = (const float*)d_in[6]; p.ffn_w_up = (const float*)d_in[7]; p.ffn_conv = (const float*)d_in[8]; p.ffn_w_down = (const float*)d_in[9];
    p.norm_g = (const float*)d_in[10]; p.out = (float*)d_out; p.ws = (unsigned char*)d_ws;
#if MK_ONE_LAUNCH
    p.ph_lo = 0; p.ph_hi = N_PHASES; p.coop = 1;
    void* args[] = {&p};
    if (hipMemsetAsync((unsigned char*)d_ws + WS_BAR, 0, 16384, stream) != hipSuccess) { fprintf(stderr, "kernel_launch: memset of the barrier words failed\n"); return; }
    hipError_t e = hipLaunchCooperativeKernel((const void*)mk_fwd, dim3(grid), dim3(512), args, LDS_BYTES, stream);
    if (e != hipSuccess) fprintf(stderr, "kernel_launch: cooperative launch failed: %s (grid %d)\n", hipGetErrorString(e), grid);
#else
    for (int ph = 0; ph < N_PHASES; ++ph) {
        p.ph_lo = ph; p.ph_hi = ph + 1; p.coop = 0;
        hipLaunchKernelGGL(mk_fwd, dim3(grid), dim3(512), LDS_BYTES, stream, p);
    }
#endif
}
```

```cpp
#include <hip/hip_runtime.h>
#include <hip/hip_cooperative_groups.h>
#include <cstdio>
namespace cg = cooperative_groups;

#ifndef MK_ONE_LAUNCH
#define MK_ONE_LAUNCH 1
#endif

#define LAS __attribute__((address_space(3)))
typedef unsigned short bf16_t;
typedef short bf16x8 __attribute__((ext_vector_type(8)));
typedef float f32x4 __attribute__((ext_vector_type(4)));
typedef unsigned u32x4 __attribute__((ext_vector_type(4)));
typedef unsigned u32x2 __attribute__((ext_vector_type(2)));

constexpr int DM = 1024, FF = 2816, SEQ = 2048, NB = 16, NMETA = 16;
constexpr int MREAL = NB * SEQ;
constexpr int MROWS = MREAL + 256;
constexpr int NTM = MROWS / 256;
constexpr int NVROWS = MREAL + NMETA;
constexpr int META_TILE = MREAL / 256;
constexpr float RMS_EPS = 1e-6f;

constexpr int BM = 256, BK = 64, HALF = 128, HTB = HALF * BK * 2, STAGE_BYTES = 8 * HTB, NXCD = 8, WGM = 8;
constexpr int XCH_BYTES = 4 * 2 * 128 * 4;
constexpr int PA_STRIDE_B = 2064;
constexpr int PM_A_BYTES = 64 * PA_STRIDE_B, PM_RED_OFF = PM_A_BYTES, PM_BYTES = PM_A_BYTES + 2 * 64 * 8 * 4;
constexpr int XBST_OFF = (STAGE_BYTES + XCH_BYTES) > PM_BYTES ? (STAGE_BYTES + XCH_BYTES) : PM_BYTES;
constexpr int LDS_BYTES = XBST_OFF + 16;

constexpr size_t al256(size_t x) { return (x + 255) & ~(size_t)255; }
constexpr size_t WS_HB    = 0;
constexpr size_t WS_F     = WS_HB + al256((size_t)MROWS * DM * 2);
constexpr size_t WS_ACT   = WS_F + al256((size_t)MROWS * DM * 2);
constexpr size_t WS_WUP   = WS_ACT + al256((size_t)MROWS * 3072 * 2);
constexpr size_t WS_WDN   = WS_WUP + al256((size_t)4 * 5632 * 1024 * 2);
constexpr size_t WS_WIN   = WS_WDN + al256((size_t)4 * 1024 * 2816 * 2);
constexpr size_t WS_WOUT  = WS_WIN + al256((size_t)2 * 3072 * 1024 * 2);
constexpr size_t WS_WP    = WS_WOUT + al256((size_t)2 * 1024 * 1024 * 2);
constexpr size_t WS_HMETA = WS_WP + al256((size_t)2 * 1024 * 256 * 2);
constexpr size_t WS_RSTD  = WS_HMETA + al256((size_t)256 * DM * 4);
constexpr size_t WS_SSF   = WS_RSTD + al256((size_t)MROWS * 4);
constexpr size_t WS_HG    = WS_SSF + al256((size_t)MROWS * 16 * 4);
constexpr size_t WS_HR    = WS_HG + al256((size_t)NTM * 2 * FF * 4);
constexpr size_t WS_ONES  = WS_HR + al256((size_t)NTM * 4 * FF * 4);
constexpr size_t WS_SSM   = WS_ONES + al256((size_t)DM * 4);
constexpr size_t WS_BAR   = WS_SSM + al256((size_t)16 * 32 * 4);
constexpr size_t WS_HB2   = WS_BAR + 16384;
constexpr size_t WS_RSTD2 = WS_HB2 + al256((size_t)MROWS * DM * 2);
constexpr size_t WS_END   = WS_RSTD2 + al256((size_t)MROWS * 4);
static_assert(WS_END <= (size_t)536870912, "workspace map exceeds 4x the largest tensor");

struct Params {
    const float* x; const float* meta; const float* pool_w; const float* pool_scale; const float* sc_w_in; const float* sc_conv; const float* sc_w_out;
    const float* ffn_w_up; const float* ffn_conv; const float* ffn_w_down; const float* norm_g;
    float* out; unsigned char* ws; int ph_lo, ph_hi, coop, pad;
};

__device__ __forceinline__ unsigned cvt_pk_bf16(float lo, float hi) { unsigned r; asm("v_cvt_pk_bf16_f32 %0, %1, %2" : "=v"(r) : "v"(lo), "v"(hi)); return r; }
__device__ __forceinline__ float bf_lo(unsigned w) { return __uint_as_float(w << 16); }
__device__ __forceinline__ float bf_hi(unsigned w) { return __uint_as_float(w & 0xffff0000u); }
__device__ __forceinline__ float wave_sum(float v) {
#pragma unroll
    for (int o = 32; o >= 1; o >>= 1) v += __shfl_xor(v, o);
    return v;
}
__device__ __forceinline__ int prev_row(int row, int k) {
    if (row < MREAL) { const int t = row & (SEQ - 1); return (t >= k) ? row - k : MREAL + NMETA + t - k; }
    const int m = row - MREAL; return (m >= k) ? row - k : -1;
}
__device__ __forceinline__ float* hrow(const Params& p, int row) { return row < MREAL ? p.out + (size_t)row * DM : (float*)(p.ws + WS_HMETA) + (size_t)(row - MREAL) * DM; }
template <int CTRL> __device__ __forceinline__ float dpp_f32(float v) { return __int_as_float(__builtin_amdgcn_update_dpp(0, __float_as_int(v), CTRL, 0xf, 0xf, true)); }
__device__ __forceinline__ float silu_mul(float c, float v) { return c * __builtin_amdgcn_rcpf(1.0f + __builtin_amdgcn_exp2f(-1.44269504089f * c)) * v; }

#define XB_TMO      128
#define XB_XCNT(j)  (256  + 64 * (j))
#define XB_XSUB(j)  (1280 + 64 * (j))
#define XB_XGEN(j)  (2304 + 64 * (j))
#define XB_TOP      3328
#define XB_TOPGEN   3392
#define XCD_BAR_WORDS 3456
#define XB_SPIN_CAP (1u << 22)
__device__ __forceinline__ unsigned xb_ld(unsigned* p)              { return __hip_atomic_load(p, __ATOMIC_RELAXED, __HIP_MEMORY_SCOPE_AGENT); }
__device__ __forceinline__ unsigned xb_add(unsigned* p, unsigned v) { return __hip_atomic_fetch_add(p, v, __ATOMIC_RELAXED, __HIP_MEMORY_SCOPE_AGENT); }
__device__ __forceinline__ unsigned xb_xcc_id() { return (unsigned)__builtin_amdgcn_s_getreg((3 << 11) | 20) & 0xFu; }
#define XB_SPIN(cond, bar) do { unsigned _sp = 0; while (cond) { __builtin_amdgcn_s_sleep(1); \
    if ((++_sp & 255u) == 0u) { if (xb_ld(&(bar)[XB_TMO])) break; if (_sp > XB_SPIN_CAP) { atomicAdd(&(bar)[XB_TMO], 1u); break; } } } } while (0)
struct XcdBarrier { unsigned* bar; unsigned x; volatile LAS unsigned* st; };
__device__ __forceinline__ void xcd_barrier_complete(unsigned* bar, unsigned x, unsigned G, unsigned& nloc, unsigned& nx) {
    unsigned sum, cnt, mine, sp = 0u;
    for (;;) {
        sum = 0u; cnt = 0u; mine = 0u;
#pragma unroll
        for (unsigned j = 0; j < 16; ++j) { const unsigned c = xb_ld(&bar[XB_XCNT(j)]); sum += c; cnt += (c > 0u) ? 1u : 0u; mine = (j == x) ? c : mine; }
        if (sum == G) break;
        __builtin_amdgcn_s_sleep(1);
        if ((++sp & 255u) == 0u) { if (xb_ld(&bar[XB_TMO])) break; if (sp > XB_SPIN_CAP) { atomicAdd(&bar[XB_TMO], 1u); break; } }
    }
    nloc = mine > 0u ? mine : 1u; nx = cnt > 0u ? cnt : 1u;
}
__device__ __forceinline__ void xcd_barrier(const XcdBarrier& b, int tid, unsigned G) {
    asm volatile("s_waitcnt vmcnt(0)" ::: "memory");
    __syncthreads();
    if (tid == 0) {
        unsigned* bar = b.bar;
        __builtin_amdgcn_s_waitcnt(0);
        unsigned nloc = b.st[0], nx = b.st[1];
        if (nloc == 0u) { xcd_barrier_complete(bar, b.x, G, nloc, nx); b.st[0] = nloc; b.st[1] = nx; }
        const unsigned old = xb_add(&bar[XB_XSUB(b.x)], 1u);
        const unsigned gen = old / nloc;
        if (old + 1u == (gen + 1u) * nloc) {
            __builtin_amdgcn_fence(__ATOMIC_RELEASE, "agent");
            asm volatile("s_waitcnt vmcnt(0)" ::: "memory");
            const unsigned og = xb_add(&bar[XB_TOP], 1u);
            const unsigned tg = og / nx;
            if (og + 1u == (tg + 1u) * nx) xb_add(&bar[XB_TOPGEN], 1u);
            else XB_SPIN(xb_ld(&bar[XB_TOPGEN]) == tg, bar);
            __builtin_amdgcn_fence(__ATOMIC_ACQUIRE, "agent");
            xb_add(&bar[XB_XGEN(b.x)], 1u);
            asm volatile("s_waitcnt vmcnt(0)" ::: "memory");
        } else {
            XB_SPIN(xb_ld(&bar[XB_XGEN(b.x)]) == gen, bar);
            __builtin_amdgcn_fence(__ATOMIC_ACQUIRE, "agent");
            asm volatile("s_waitcnt vmcnt(0)" ::: "memory");
        }
    }
    __syncthreads();
}

__device__ __forceinline__ int lds_byte(int r, int c) { const int st = (r >> 4) * 2 + (c >> 5), rr = r & 15, cc = c & 31, ob = rr * 64 + cc * 2; return st * 1024 + (ob ^ (((ob >> 9) & 1) << 5)); }
__device__ __forceinline__ void stage_rc(int b, int& R, int& C) { const int st = b / 1024, sb = b % 1024, swz = sb ^ (((sb >> 9) & 1) << 5); R = (st >> 1) * 16 + swz / 64; C = (st & 1) * 32 + (swz % 64) / 2; }
__device__ __forceinline__ int perm32(int rho) { const int n = rho >> 4, i = rho & 15; return 8 * (i >> 2) + 4 * n + (i & 3); }

struct Ctx { int tid, bid, nblk; };
__device__ __forceinline__ void lds_barrier() { asm volatile("s_waitcnt lgkmcnt(0)" ::: "memory"); __builtin_amdgcn_s_barrier(); asm volatile("" ::: "memory"); }
struct Unit { int pm, pn; };
struct Gemm { const bf16_t* A; const bf16_t* Bt; int M, N, K, lda, ldb, a_pn_bytes; };

struct StaticOrder {
    int nM, nN, nwg, G, c;
    __device__ void init(int M, int N, int G_, int c_) { nM = M / BM; nN = N / BM; nwg = nM * nN; G = G_; c = c_; }
    __device__ bool next(int i, Unit& u) const {
        const long L = (long)i * G + c; if (L >= nwg) return false;
        int wgid = (int)L; { const int q = nwg / NXCD, r = nwg % NXCD, xcd = wgid % NXCD, off = wgid / NXCD; wgid = (xcd < r ? xcd * (q + 1) : r * (q + 1) + (xcd - r) * q) + off; }
        const int nig = WGM * nN, gid = wgid / nig, fm = gid * WGM, gsz = (nM - fm) < WGM ? (nM - fm) : WGM;
        u.pm = fm + ((wgid % nig) % gsz); u.pn = (wgid % nig) / gsz; return true;
    }
};

struct EpiF {
    bf16_t* F; float* ssp; const float* scale;
    __device__ __forceinline__ void operator()(f32x4 (&acc)[2][2][4][2], const Unit& u, int wr, int wc, int fr, int fq, LAS unsigned char*) const {
        asm volatile("" : "+v"(fr), "+v"(fq), "+s"(wr), "+s"(wc));
        const int row0 = u.pm * BM + wr * 64 + fr, col0 = u.pn * BM + wc * 32 + 8 * fq;
        f32x4 sc[2][2];
#pragma unroll
        for (int bj = 0; bj < 2; ++bj)
#pragma unroll
            for (int n = 0; n < 2; ++n) sc[bj][n] = *(const f32x4*)(scale + col0 + bj * HALF + 4 * n);
#pragma unroll
        for (int ai = 0; ai < 2; ++ai)
#pragma unroll
            for (int m = 0; m < 4; ++m) {
                const int row = row0 + ai * HALF + m * 16; float s = 0.f;
#pragma unroll
                for (int bj = 0; bj < 2; ++bj) {
                    const f32x4 v0 = acc[ai][bj][m][0] * sc[bj][0], v1 = acc[ai][bj][m][1] * sc[bj][1];
                    s += (v0[0] * v0[0] + v0[1] * v0[1]) + (v0[2] * v0[2] + v0[3] * v0[3]) + (v1[0] * v1[0] + v1[1] * v1[1]) + (v1[2] * v1[2] + v1[3] * v1[3]);
                    u32x4 w; w.x = cvt_pk_bf16(v0[0], v0[1]); w.y = cvt_pk_bf16(v0[2], v0[3]); w.z = cvt_pk_bf16(v1[0], v1[1]); w.w = cvt_pk_bf16(v1[2], v1[3]);
                    *(u32x4*)(F + (size_t)row * DM + col0 + bj * HALF) = w;
                }
                s += __shfl_xor(s, 16); s += __shfl_xor(s, 32);
                if (fq == 0) ssp[(size_t)row * 16 + u.pn * 4 + wc] = s;
            }
    }
};
struct EpiIn {
    bf16_t* CV; bf16_t* Bb; const float* rstd;
    __device__ __forceinline__ void operator()(f32x4 (&acc)[2][2][4][2], const Unit& u, int wr, int wc, int fr, int fq, LAS unsigned char*) const {
        asm volatile("" : "+v"(fr), "+v"(fq), "+s"(wr), "+s"(wc));
        const int row0 = u.pm * BM + wr * 64 + fr;
        float rs[2][4];
#pragma unroll
        for (int ai = 0; ai < 2; ++ai)
#pragma unroll
            for (int m = 0; m < 4; ++m) rs[ai][m] = rstd[row0 + ai * HALF + m * 16];
        if (u.pn < 8) {
            const int col0 = u.pn * HALF + wc * 32 + 8 * fq;
#pragma unroll
            for (int ai = 0; ai < 2; ++ai)
#pragma unroll
                for (int m = 0; m < 4; ++m) {
                    const int row = row0 + ai * HALF + m * 16; const float r2 = rs[ai][m] * rs[ai][m];
                    const f32x4 v0 = acc[ai][0][m][0] * acc[ai][1][m][0] * r2, v1 = acc[ai][0][m][1] * acc[ai][1][m][1] * r2;
                    u32x4 w; w.x = cvt_pk_bf16(v0[0], v0[1]); w.y = cvt_pk_bf16(v0[2], v0[3]); w.z = cvt_pk_bf16(v1[0], v1[1]); w.w = cvt_pk_bf16(v1[2], v1[3]);
                    *(u32x4*)(CV + (size_t)row * DM + col0) = w;
                }
        } else {
            const int col0 = (u.pn - 8) * BM + wc * 32 + 8 * fq;
#pragma unroll
            for (int ai = 0; ai < 2; ++ai)
#pragma unroll
                for (int m = 0; m < 4; ++m) {
                    const int row = row0 + ai * HALF + m * 16; const float r = rs[ai][m];
#pragma unroll
                    for (int bj = 0; bj < 2; ++bj) {
                        const f32x4 v0 = acc[ai][bj][m][0] * r, v1 = acc[ai][bj][m][1] * r;
                        u32x4 w; w.x = cvt_pk_bf16(v0[0], v0[1]); w.y = cvt_pk_bf16(v0[2], v0[3]); w.z = cvt_pk_bf16(v1[0], v1[1]); w.w = cvt_pk_bf16(v1[2], v1[3]);
                        *(u32x4*)(Bb + (size_t)row * DM + col0 + bj * HALF) = w;
                    }
                }
        }
    }
};
struct EpiUp {
    bf16_t* A; const float* rstd; const float* cw; float* hg; float* hr;
    __device__ __forceinline__ void operator()(f32x4 (&acc)[2][2][4][2], const Unit& u, int wr, int wc, int fr, int fq, LAS unsigned char* lds) const {
        asm volatile("" : "+v"(fr), "+v"(fq), "+s"(wr), "+s"(wc));
        LAS float* X = (LAS float*)(lds + STAGE_BYTES);
        const int lane = fq * 16 + fr;
        const int jl = wc * 32 + 8 * fq, j0 = u.pn * HALF + jl, rowt = wr * 64 + fr;
        float rs[2][4];
#pragma unroll
        for (int ai = 0; ai < 2; ++ai)
#pragma unroll
            for (int m = 0; m < 4; ++m) rs[ai][m] = rstd[u.pm * BM + ai * HALF + m * 16 + rowt];
        f32x4 w0[2], w1[2], w2[2];
#pragma unroll
        for (int n = 0; n < 2; ++n) { w0[n] = *(const f32x4*)(cw + j0 + 4 * n); w1[n] = *(const f32x4*)(cw + FF + j0 + 4 * n); w2[n] = *(const f32x4*)(cw + 2 * FF + j0 + 4 * n); }
#pragma unroll
        for (int ai = 0; ai < 2; ++ai)
#pragma unroll
            for (int m = 0; m < 4; ++m) {
#pragma unroll
                for (int bj = 0; bj < 2; ++bj)
#pragma unroll
                    for (int n = 0; n < 2; ++n) acc[ai][bj][m][n] *= rs[ai][m];
            }
        const bool meta = (u.pm == META_TILE);
        if (fr >= 14) {
#pragma unroll
            for (int ai = 0; ai < 2; ++ai)
#pragma unroll
                for (int n = 0; n < 2; ++n) *(LAS f32x4*)(X + ((2 * ai + wr) * 2 + (fr - 14)) * 128 + jl + 4 * n) = acc[ai][0][3][n];
            if (meta) { if (wr == 0) {
#pragma unroll
                for (int n = 0; n < 2; ++n) *(f32x4*)(hg + ((size_t)u.pm * 2 + (fr - 14)) * FF + j0 + 4 * n) = acc[0][0][0][n]; }
            } else if (wr == 1) {
#pragma unroll
                for (int n = 0; n < 2; ++n) *(f32x4*)(hg + ((size_t)u.pm * 2 + (fr - 14)) * FF + j0 + 4 * n) = acc[1][0][3][n];
            }
        }
        if (fr < 2 && wr == 0) {
#pragma unroll
            for (int n = 0; n < 2; ++n) {
                *(f32x4*)(hr + (((size_t)u.pm * 2 + fr) * 2 + 0) * FF + j0 + 4 * n) = acc[0][0][0][n];
                *(f32x4*)(hr + (((size_t)u.pm * 2 + fr) * 2 + 1) * FF + j0 + 4 * n) = acc[0][1][0][n];
            }
        }
        asm volatile("s_waitcnt lgkmcnt(0)" ::: "memory"); __builtin_amdgcn_s_barrier(); asm volatile("" ::: "memory");
        f32x4 w1b[2], w0b[2];
#pragma unroll
        for (int n = 0; n < 2; ++n)
#pragma unroll
            for (int e = 0; e < 4; ++e) { w1b[n][e] = (fr == 0) ? w1[n][e] : 0.f; w0b[n][e] = (fr < 2) ? w0[n][e] : 0.f; }
#pragma unroll
        for (int ai = 0; ai < 2; ++ai) {
            const int q = 2 * ai + wr;
            f32x4 gp[2];
#pragma unroll
            for (int n = 0; n < 2; ++n) { gp[n] = (f32x4){0.f, 0.f, 0.f, 0.f}; if (q > 0 && fr >= 14) gp[n] = *(LAS f32x4*)(X + ((q - 1) * 2 + (fr - 14)) * 128 + jl + 4 * n); }
#pragma unroll
            for (int m = 0; m < 4; ++m) {
                const int row = u.pm * BM + ai * HALF + m * 16 + rowt;
                u32x4 pk;
#pragma unroll
                for (int n = 0; n < 2; ++n) {
                    const f32x4 G = acc[ai][0][m][n], Gp = (m == 0) ? gp[n] : acc[ai][0][m == 0 ? 0 : m - 1][n], V = acc[ai][1][m][n];
                    f32x4 o;
#pragma unroll
                    for (int e = 0; e < 4; ++e) {
                        float c = w2[n][e] * G[e];
                        asm("s_nop 1\n\tv_fmac_f32_dpp %0, %1, %2 row_shr:1 row_mask:0xf bank_mask:0xf bound_ctrl:1" : "+v"(c) : "v"(G[e]), "v"(w1[n][e]));
                        asm("v_fmac_f32_dpp %0, %1, %2 row_shr:2 row_mask:0xf bank_mask:0xf bound_ctrl:1" : "+v"(c) : "v"(G[e]), "v"(w0[n][e]));
                        asm("s_nop 1\n\tv_fmac_f32_dpp %0, %1, %2 row_ror:1 row_mask:0xf bank_mask:0xf bound_ctrl:1" : "+v"(c) : "v"(Gp[e]), "v"(w1b[n][e]));
                        asm("v_fmac_f32_dpp %0, %1, %2 row_ror:2 row_mask:0xf bank_mask:0xf bound_ctrl:1" : "+v"(c) : "v"(Gp[e]), "v"(w0b[n][e]));
                        o[e] = silu_mul(c, V[e]);
                    }
                    if (n == 0) { pk.x = cvt_pk_bf16(o[0], o[1]); pk.y = cvt_pk_bf16(o[2], o[3]); } else { pk.z = cvt_pk_bf16(o[0], o[1]); pk.w = cvt_pk_bf16(o[2], o[3]); }
                }
                if (!(ai == 0 && m == 0 && wr == 0 && fr < 2)) *(u32x4*)(A + (size_t)row * FF + j0) = pk;
            }
        }
    }
};

template <class Epi>
__device__ __forceinline__ void gemm_phase(const Ctx cx, LAS unsigned char* lds, const Gemm g, const StaticOrder& S, const Epi& E) {
    const int tid = cx.tid, wid = __builtin_amdgcn_readfirstlane(tid >> 6), lane = tid & 63, wr = wid >> 2, wc = wid & 3, fr = lane & 15, fq = lane >> 4;
    const int nt = g.K / BK;
    unsigned voffA[2], voffB[2];
#pragma unroll
    for (int i = 0; i < 2; ++i) { int R, C; stage_rc(tid * 16 + i * 8192, R, C); const int Rb = (R & ~31) + perm32(R & 31);
        voffA[i] = (unsigned)(R * g.lda + C) * 2u; voffB[i] = (unsigned)(Rb * g.ldb + C) * 2u; }
    const size_t kstep = (size_t)(BK * 2);
    const size_t hstepA = (size_t)HALF * g.lda * 2, hstepB = (size_t)HALF * g.ldb * 2;
    const size_t tstepA = 2 * hstepA, tstepB = 2 * hstepB;
    const unsigned ldsw = (unsigned)wid * 1024u;
    const int aoff = lds_byte(wr * 64 + fr, fq * 8), boff = lds_byte(wc * 32 + fr, fq * 8);
#define PG8_SA(b, h) (((b) * 2 + (h)) * HTB)
#define PG8_SB(b, h) ((4 + (b) * 2 + (h)) * HTB)
#define PG8_STAGE(bufoff, gbase, voff) do { _Pragma("unroll") for (int _i = 0; _i < 2; ++_i) \
        __builtin_amdgcn_global_load_lds((const unsigned*)((const char*)(gbase) + (voff)[_i]), (LAS unsigned*)(lds + (bufoff) + ldsw + _i * 8192), 16, 0, 0); } while (0)
#define PG8_LDA(dst, b, h) do { _Pragma("unroll") for (int m = 0; m < 4; ++m) _Pragma("unroll") for (int k = 0; k < 2; ++k) dst[m][k] = *(const LAS bf16x8*)(lds + PG8_SA(b, h) + aoff + m * 2048 + k * 1024); } while (0)
#define PG8_LDB(dst, b, h) do { _Pragma("unroll") for (int n = 0; n < 2; ++n) _Pragma("unroll") for (int k = 0; k < 2; ++k) dst[n][k] = *(const LAS bf16x8*)(lds + PG8_SB(b, h) + boff + n * 2048 + k * 1024); } while (0)
#define PG8_MMA1(ai, bj, At, Bt) do { _Pragma("unroll") for (int m = 0; m < 4; ++m) _Pragma("unroll") for (int n = 0; n < 2; ++n) _Pragma("unroll") for (int k = 0; k < 2; ++k) \
        acc[ai][bj][m][n] = __builtin_amdgcn_mfma_f32_16x16x32_bf16(Bt[n][k], At[m][k], acc[ai][bj][m][n], 0, 0, 0); } while (0)
#define PG8_MMA2(ai, At, Ba, Bb) do { __builtin_amdgcn_s_setprio(1); PG8_MMA1(ai, 0, At, Ba); PG8_MMA1(ai, 1, At, Bb); __builtin_amdgcn_s_setprio(0); } while (0)
#define PG8_WAIT_V(n) asm volatile("s_waitcnt vmcnt(" #n ")" ::: "memory")
#define PG8_WAIT_L(n) asm volatile("s_waitcnt lgkmcnt(" #n ")" ::: "memory")
#define PG8_BAR __builtin_amdgcn_s_barrier()
#define PG8_SCHED __builtin_amdgcn_sched_barrier(0)
    Unit cur, nxt; int ui = 0;
    if (!S.next(0, cur)) return;
    f32x4 acc[2][2][4][2];
#pragma unroll
    for (int a = 0; a < 2; ++a)
#pragma unroll
        for (int b = 0; b < 2; ++b)
#pragma unroll
            for (int m = 0; m < 4; ++m)
#pragma unroll
                for (int n = 0; n < 2; ++n) acc[a][b][m][n] = (f32x4){0.f, 0.f, 0.f, 0.f};
    bf16x8 At[4][2], B0[2][2], B1[2][2];
    const char* cA = (const char*)g.A + (size_t)cur.pm * tstepA + (size_t)cur.pn * g.a_pn_bytes; const char* cB = (const char*)g.Bt + (size_t)cur.pn * tstepB;
    PG8_STAGE(PG8_SB(0, 0), cB, voffB); PG8_STAGE(PG8_SB(0, 1), cB + hstepB, voffB); PG8_STAGE(PG8_SA(0, 0), cA, voffA); PG8_STAGE(PG8_SA(0, 1), cA + hstepA, voffA);
    if (wr == 1) PG8_BAR;
    PG8_WAIT_V(2); PG8_BAR;
    PG8_STAGE(PG8_SB(1, 0), cB + kstep, voffB); PG8_STAGE(PG8_SA(1, 0), cA + kstep, voffA); PG8_STAGE(PG8_SB(1, 1), cB + hstepB + kstep, voffB);
    PG8_WAIT_V(6); PG8_BAR;
    for (;;) {
        const bool has_next = S.next(ui + 1, nxt);
        const char* nA = has_next ? (const char*)g.A + (size_t)nxt.pm * tstepA + (size_t)nxt.pn * g.a_pn_bytes : cA; const char* nB = has_next ? (const char*)g.Bt + (size_t)nxt.pn * tstepB : cB;
        for (int t = 0; t < nt; t += 2) {
            const bool last = (t == nt - 2);
            const char* a1 = cA + (size_t)(t + 1) * kstep;
            const char* a2 = last ? nA : cA + (size_t)(t + 2) * kstep; const char* b2 = last ? nB : cB + (size_t)(t + 2) * kstep;
            const char* a3 = a2 + kstep; const char* b3 = b2 + kstep;
            PG8_LDB(B0, 0, 0); PG8_LDB(B1, 0, 1); PG8_SCHED; PG8_LDA(At, 0, 0); PG8_STAGE(PG8_SA(1, 1), a1 + hstepA, voffA);
            PG8_WAIT_V(8); PG8_WAIT_L(0); PG8_BAR; PG8_MMA2(0, At, B0, B1); PG8_BAR; PG8_SCHED;
            PG8_LDA(At, 0, 1); PG8_STAGE(PG8_SB(0, 0), b2, voffB); PG8_STAGE(PG8_SB(0, 1), b2 + hstepB, voffB); PG8_STAGE(PG8_SA(0, 0), a2, voffA);
            PG8_WAIT_V(8); PG8_WAIT_L(0); PG8_BAR; PG8_MMA2(1, At, B0, B1); PG8_BAR; PG8_SCHED;
            PG8_LDB(B0, 1, 0); PG8_LDB(B1, 1, 1); PG8_SCHED; PG8_LDA(At, 1, 0); PG8_STAGE(PG8_SA(0, 1), a2 + hstepA, voffA);
            PG8_WAIT_V(8); PG8_WAIT_L(0); PG8_BAR; PG8_MMA2(0, At, B0, B1); PG8_BAR; PG8_SCHED;
            PG8_LDA(At, 1, 1); PG8_STAGE(PG8_SB(1, 0), b3, voffB); PG8_STAGE(PG8_SB(1, 1), b3 + hstepB, voffB); PG8_STAGE(PG8_SA(1, 0), a3, voffA);
            PG8_WAIT_V(8); PG8_WAIT_L(0); PG8_BAR; PG8_MMA2(1, At, B0, B1); PG8_BAR; PG8_SCHED;
        }
        if (wr == 0) PG8_BAR;
        E(acc, cur, wr, wc, fr, fq, lds);
        if (!has_next) break;
#pragma unroll
        for (int a = 0; a < 2; ++a)
#pragma unroll
            for (int b = 0; b < 2; ++b)
#pragma unroll
                for (int m = 0; m < 4; ++m)
#pragma unroll
                    for (int n = 0; n < 2; ++n) acc[a][b][m][n] = (f32x4){0.f, 0.f, 0.f, 0.f};
        cur = nxt; cA = nA; cB = nB; ++ui;
        if (wr == 1) PG8_BAR;
    }
    PG8_WAIT_V(0);
    PG8_BAR;
#undef PG8_SA
#undef PG8_SB
#undef PG8_STAGE
#undef PG8_LDA
#undef PG8_LDB
#undef PG8_MMA1
#undef PG8_MMA2
#undef PG8_WAIT_V
#undef PG8_WAIT_L
#undef PG8_BAR
#undef PG8_SCHED
}

struct SkF {
    bf16_t* F; float* ssm; const float* scale; int pool;
    __device__ __forceinline__ void item(int it, int& n0a, int& n0b, int& acol) const { n0a = 32 * it; n0b = n0a + 16; acol = pool ? (n0a >> 8) * 256 : 0; }
    __device__ __forceinline__ void epi(int it, int lane, f32x4 v0, f32x4 v1) const {
        const int fr = lane & 15, fq = lane >> 4, ca = 32 * it + 4 * fq, cb = ca + 16;
        v0 *= *(const f32x4*)(scale + ca); v1 *= *(const f32x4*)(scale + cb);
        u32x2 wa, wb; wa.x = cvt_pk_bf16(v0[0], v0[1]); wa.y = cvt_pk_bf16(v0[2], v0[3]); wb.x = cvt_pk_bf16(v1[0], v1[1]); wb.y = cvt_pk_bf16(v1[2], v1[3]);
        *(u32x2*)(F + (size_t)(MREAL + fr) * DM + ca) = wa; *(u32x2*)(F + (size_t)(MREAL + fr) * DM + cb) = wb;
        float ss = (v0[0] * v0[0] + v0[1] * v0[1]) + (v0[2] * v0[2] + v0[3] * v0[3]) + (v1[0] * v1[0] + v1[1] * v1[1]) + (v1[2] * v1[2] + v1[3] * v1[3]);
        ss += __shfl_xor(ss, 16); ss += __shfl_xor(ss, 32);
        if (fq == 0) ssm[fr * 32 + it] = ss;
    }
};
struct SkUp {
    bf16_t* A; const float* rstd; const float* cw; float* hg;
    __device__ __forceinline__ void item(int it, int& n0a, int& n0b, int& acol) const { n0a = (it >> 3) * 256 + (it & 7) * 16; n0b = n0a + 128; acol = 0; }
    __device__ __forceinline__ void epi(int it, int lane, f32x4 v0, f32x4 v1) const {
        const int fr = lane & 15, fq = lane >> 4, j = (it >> 3) * 128 + (it & 7) * 16 + 4 * fq;
        const float r = rstd[MREAL + fr];
        const f32x4 g = v0 * r, val = v1 * r;
        const f32x4 w0 = *(const f32x4*)(cw + j), w1 = *(const f32x4*)(cw + FF + j), w2 = *(const f32x4*)(cw + 2 * FF + j);
        f32x4 o;
#pragma unroll
        for (int e = 0; e < 4; ++e) {
            float p1 = __shfl(g[e], (lane + 63) & 63), p2 = __shfl(g[e], (lane + 62) & 63);
            p1 = fr >= 1 ? p1 : 0.f; p2 = fr >= 2 ? p2 : 0.f;
            o[e] = silu_mul(w0[e] * p2 + w1[e] * p1 + w2[e] * g[e], val[e]);
        }
        u32x2 w; w.x = cvt_pk_bf16(o[0], o[1]); w.y = cvt_pk_bf16(o[2], o[3]);
        *(u32x2*)(A + (size_t)(MREAL + fr) * FF + j) = w;
        if (fr >= 14) *(f32x4*)(hg + ((size_t)META_TILE * 2 + (fr - 14)) * FF + j) = g;
    }
};
struct SkIn {
    bf16_t* CV; bf16_t* Bb; const float* rstd;
    __device__ __forceinline__ void item(int it, int& n0a, int& n0b, int& acol) const {
        if (it < 64) { n0a = (it >> 3) * 256 + (it & 7) * 16; n0b = n0a + 128; } else { n0a = 2048 + 32 * (it - 64); n0b = n0a + 16; } acol = 0; }
    __device__ __forceinline__ void epi(int it, int lane, f32x4 v0, f32x4 v1) const {
        const int fr = lane & 15, fq = lane >> 4; const float r = rstd[MREAL + fr];
        if (it < 64) { const f32x4 cv = v0 * v1 * (r * r); u32x2 w; w.x = cvt_pk_bf16(cv[0], cv[1]); w.y = cvt_pk_bf16(cv[2], cv[3]);
            *(u32x2*)(CV + (size_t)(MREAL + fr) * DM + (it >> 3) * 128 + (it & 7) * 16 + 4 * fq) = w; }
        else { const f32x4 a = v0 * r, b = v1 * r; u32x2 wa, wb; wa.x = cvt_pk_bf16(a[0], a[1]); wa.y = cvt_pk_bf16(a[2], a[3]); wb.x = cvt_pk_bf16(b[0], b[1]); wb.y = cvt_pk_bf16(b[2], b[3]);
            const int c = 32 * (it - 64) + 4 * fq; *(u32x2*)(Bb + (size_t)(MREAL + fr) * DM + c) = wa; *(u32x2*)(Bb + (size_t)(MREAL + fr) * DM + c + 16) = wb; }
    }
};
template <int KS, class SE>
__device__ __forceinline__ void skinny_gemm(const Ctx cx, LAS unsigned char* lds, const bf16_t* A16, int lda, const bf16_t* Bt, int ldb, int nitems, const SE& E) {
    const int tid = cx.tid, wid = __builtin_amdgcn_readfirstlane(tid >> 6), lane = tid & 63, fr = lane & 15, fq = lane >> 4;
    LAS float* red = (LAS float*)lds;
    for (int it = cx.bid; it < nitems; it += cx.nblk) {
        int n0a, n0b, acol; E.item(it, n0a, n0b, acol);
        const int kofs = wid * KS * 32 + fq * 8;
        const bf16_t* ap = A16 + (size_t)fr * lda + acol + kofs;
        const bf16_t* bp0 = Bt + (size_t)(n0a + fr) * ldb + kofs;
        const bf16_t* bp1 = Bt + (size_t)(n0b + fr) * ldb + kofs;
        bf16x8 a[KS], b0[KS], b1[KS];
#pragma unroll
        for (int q = 0; q < KS; ++q) { a[q] = *(const bf16x8*)(ap + q * 32); b0[q] = *(const bf16x8*)(bp0 + q * 32); b1[q] = *(const bf16x8*)(bp1 + q * 32); }
        f32x4 c0 = (f32x4){0.f, 0.f, 0.f, 0.f}, c1 = (f32x4){0.f, 0.f, 0.f, 0.f};
#pragma unroll
        for (int q = 0; q < KS; ++q) { c0 = __builtin_amdgcn_mfma_f32_16x16x32_bf16(b0[q], a[q], c0, 0, 0, 0); c1 = __builtin_amdgcn_mfma_f32_16x16x32_bf16(b1[q], a[q], c1, 0, 0, 0); }
        *(LAS f32x4*)(red + (wid * 64 + lane) * 8) = c0; *(LAS f32x4*)(red + (wid * 64 + lane) * 8 + 4) = c1;
        __syncthreads();
        if (wid == 0) {
#pragma unroll
            for (int w = 1; w < 8; ++w) { c0 += *(LAS f32x4*)(red + (w * 64 + lane) * 8); c1 += *(LAS f32x4*)(red + (w * 64 + lane) * 8 + 4); }
            E.epi(it, lane, c0, c1);
        }
        __syncthreads();
    }
}

struct TrDesc { const float* src; const float* gain; bf16_t* dst; int ldw, ldo; };
__device__ __forceinline__ TrDesc tr_desc(const Params& p, int i) {
    bf16_t* wup = (bf16_t*)(p.ws + WS_WUP); bf16_t* wdn = (bf16_t*)(p.ws + WS_WDN); bf16_t* win = (bf16_t*)(p.ws + WS_WIN); bf16_t* wout = (bf16_t*)(p.ws + WS_WOUT); bf16_t* wp = (bf16_t*)(p.ws + WS_WP);
    constexpr int T_UP = 4 * 88 * 16, T_DN = 4 * 16 * 44, T_IN = 2 * 48 * 16, T_OUT = 2 * 16 * 16;
    TrDesc d;
    if (i < T_UP) { const int L = i / (88 * 16), r = i % (88 * 16), nb = r / 16, kb = r % 16; const int n0 = nb * 64, chunk = n0 >> 7, pn = chunk >> 1, h = chunk & 1;
        d.ldw = 2 * FF; d.ldo = DM; d.src = p.ffn_w_up + (size_t)L * DM * 2 * FF + (size_t)(kb * 64) * d.ldw + h * FF + pn * 128 + (n0 & 127);
        d.gain = p.norm_g + (L * 4 + 2) * DM + kb * 64; d.dst = wup + (size_t)L * 5632 * DM + (size_t)n0 * DM + kb * 64; return d; }
    i -= T_UP;
    if (i < T_DN) { const int L = i / (16 * 44), r = i % (16 * 44), nb = r / 44, kb = r % 44;
        d.ldw = DM; d.ldo = FF; d.src = p.ffn_w_down + (size_t)L * FF * DM + (size_t)(kb * 64) * DM + nb * 64; d.gain = nullptr; d.dst = wdn + (size_t)L * DM * FF + (size_t)(nb * 64) * FF + kb * 64; return d; }
    i -= T_DN;
    if (i < T_IN) { const int j = i / (48 * 16), r = i % (48 * 16), nb = r / 16, kb = r % 16; const int n0 = nb * 64, chunk = n0 >> 7;
        const int c0 = (chunk < 16) ? (DM * (1 + (chunk & 1)) + (chunk >> 1) * 128 + (n0 & 127)) : ((chunk - 16) * 128 + (n0 & 127));
        d.ldw = 3 * DM; d.ldo = DM; d.src = p.sc_w_in + (size_t)j * DM * 3 * DM + (size_t)(kb * 64) * d.ldw + c0; d.gain = p.norm_g + ((2 * j + 1) * 4 + 0) * DM + kb * 64;
        d.dst = win + (size_t)j * 3072 * DM + (size_t)n0 * DM + kb * 64; return d; }
    i -= T_IN;
    if (i < T_OUT) { const int j = i / 256, r = i % 256, nb = r / 16, kb = r % 16;
        d.ldw = DM; d.ldo = DM; d.src = p.sc_w_out + (size_t)j * DM * DM + (size_t)(kb * 64) * DM + nb * 64; d.gain = nullptr; d.dst = wout + (size_t)j * DM * DM + (size_t)(nb * 64) * DM + kb * 64; return d; }
    i -= T_OUT;
    { const int j = i / 64, r = i % 64, gI = r / 16, nb = (r % 16) / 4, kb = r % 4;
        d.ldw = 256; d.ldo = 256; d.src = p.pool_w + ((size_t)j * 4 + gI) * 256 * 256 + (size_t)(kb * 64) * 256 + nb * 64; d.gain = p.norm_g + ((2 * j) * 4 + 0) * DM + gI * 256 + kb * 64;
        d.dst = wp + ((size_t)j * 1024 + gI * 256 + nb * 64) * 256 + kb * 64; return d; }
}
__device__ __forceinline__ void tr_load(const TrDesc& d, int tx, int ty, float (&v)[8]) {
    const int tid = ty * 64 + tx, kk = tid >> 4, c4 = (tid & 15) * 4;
#pragma unroll
    for (int h = 0; h < 2; ++h) { const int k = kk + 32 * h; f32x4 x = *(const f32x4*)(d.src + (size_t)k * d.ldw + c4); if (d.gain) x *= d.gain[k];
        v[4 * h] = x[0]; v[4 * h + 1] = x[1]; v[4 * h + 2] = x[2]; v[4 * h + 3] = x[3]; }
}
__device__ void phase_prologue(const Ctx cx, const Params& p, LAS unsigned char* lds) {
    LAS float* t = (LAS float*)lds;
    constexpr int T_ALL = 4 * 88 * 16 + 4 * 16 * 44 + 2 * 48 * 16 + 2 * 16 * 16;
    const int tid = cx.tid, tx = tid & 63, ty = tid >> 6, wid = tid >> 6, lane = tid & 63;
    {
        int it = cx.bid; float v[8]; TrDesc d = tr_desc(p, it < T_ALL ? it : 0);
        if (it < T_ALL) tr_load(d, tx, ty, v);
        while (it < T_ALL) {
#pragma unroll
            for (int q = 0; q < 8; ++q) t[((tid >> 4) + 32 * (q >> 2)) * 65 + (tid & 15) * 4 + (q & 3)] = v[q];
            lds_barrier();
            const int itn = it + cx.nblk; TrDesc dn = d;
            if (itn < T_ALL) { dn = tr_desc(p, itn); tr_load(dn, tx, ty, v); }
            const int n = tid >> 3, ks = tid & 7; float o[8];
#pragma unroll
            for (int i = 0; i < 8; ++i) o[i] = t[(ks * 8 + i) * 65 + n];
            u32x4 w; w.x = cvt_pk_bf16(o[0], o[1]); w.y = cvt_pk_bf16(o[2], o[3]); w.z = cvt_pk_bf16(o[4], o[5]); w.w = cvt_pk_bf16(o[6], o[7]);
            *(u32x4*)(d.dst + (size_t)n * d.ldo + ks * 8) = w;
            lds_barrier();
            it = itn; d = dn;
        }
    }
    bf16_t* Hb = (bf16_t*)(p.ws + WS_HB); float* rstd = (float*)(p.ws + WS_RSTD);
    const int stride = cx.nblk * 8;
    for (int row = cx.bid * 8 + wid; row < NVROWS; row += 2 * stride) {
        f32x4 v[2][4];
#pragma unroll
        for (int h = 0; h < 2; ++h) { const int rw = row + h * stride; const int m = rw - MREAL;
            const float* src = rw < MREAL ? p.x + (size_t)rw * DM : ((m < NMETA) ? p.meta + (size_t)m * DM : nullptr);
#pragma unroll
            for (int c = 0; c < 4; ++c) v[h][c] = (src && rw < NVROWS) ? *(const f32x4*)(src + c * 256 + lane * 4) : (f32x4){0.f, 0.f, 0.f, 0.f}; }
#pragma unroll
        for (int h = 0; h < 2; ++h) { const int rw = row + h * stride; if (rw >= NVROWS) break;
            float ss = 0.f;
#pragma unroll
            for (int c = 0; c < 4; ++c) { const int col = c * 256 + lane * 4; const f32x4 x = v[h][c];
                u32x2 w; w.x = cvt_pk_bf16(x[0], x[1]); w.y = cvt_pk_bf16(x[2], x[3]); *(u32x2*)(Hb + (size_t)rw * DM + col) = w;
                const float q0 = bf_lo(w.x), q1 = bf_hi(w.x), q2 = bf_lo(w.y), q3 = bf_hi(w.y); ss += (q0 * q0 + q1 * q1) + (q2 * q2 + q3 * q3); }
            ss = wave_sum(ss);
            if (lane == 0) rstd[rw] = 1.0f / sqrtf(ss * (1.0f / DM) + RMS_EPS); }
    }
    if (cx.bid == 0) { float* ones = (float*)(p.ws + WS_ONES); for (int i = cx.tid; i < DM; i += 512) ones[i] = 1.0f; }
    {
        bf16_t* wp = (bf16_t*)(p.ws + WS_WP);
        for (int f = cx.bid * 512 + cx.tid; f < 2 * 8 * 8 * 8 * 64; f += cx.nblk * 512) {
            const int ln = f & 63, ks = (f >> 6) & 7, nb = (f >> 9) & 7, wv = (f >> 12) & 7, j = f >> 15, fr = ln & 15, fq = ln >> 4;
            const int row = 128 * wv + 32 * (nb >> 1) + perm32(16 * (nb & 1) + fr), gI = row >> 8, nn = row & 255, k0 = 32 * ks + 8 * fq;
            const float* src = p.pool_w + (((size_t)j * 4 + gI) * 256 + k0) * 256 + nn; const float* gn = p.norm_g + ((2 * j) * 4 + 0) * DM + gI * 256 + k0;
            float v[8];
#pragma unroll
            for (int i = 0; i < 8; ++i) v[i] = src[(size_t)i * 256] * gn[i];
            u32x4 o; o.x = cvt_pk_bf16(v[0], v[1]); o.y = cvt_pk_bf16(v[2], v[3]); o.z = cvt_pk_bf16(v[4], v[5]); o.w = cvt_pk_bf16(v[6], v[7]);
            *(u32x4*)(wp + (size_t)f * 8) = o;
        }
    }
}

__device__ void phase_eres(const Ctx cx, const Params& p, bf16_t* Hb, float* rstd, const float* g, bool last) {
    const int wid = cx.tid >> 6, lane = cx.tid & 63;
    const bf16_t* F = (const bf16_t*)(p.ws + WS_F); const float* ssp = (const float*)(p.ws + WS_SSF);
    const int nrows = last ? MREAL : NVROWS; const float* ssm = (const float*)(p.ws + WS_SSM);
    f32x4 gv[2][2];
#pragma unroll
    for (int c = 0; c < 2; ++c) { gv[c][0] = *(const f32x4*)(g + c * 512 + lane * 8); gv[c][1] = *(const f32x4*)(g + c * 512 + lane * 8 + 4); }
    const int stride = cx.nblk * 8;
    for (int row = cx.bid * 8 + wid; row < nrows; row += 2 * stride) {
        u32x4 hw[2][2], fw[2][2]; float sp[2];
#pragma unroll
        for (int h = 0; h < 2; ++h) { int rw = row + h * stride; rw = rw < nrows ? rw : row;
            sp[h] = rw < MREAL ? (lane < 16 ? ssp[(size_t)rw * 16 + lane] : 0.f) : (lane < 32 ? ssm[(rw - MREAL) * 32 + lane] : 0.f);
#pragma unroll
            for (int c = 0; c < 2; ++c) { const int col = c * 512 + lane * 8; hw[h][c] = *(const u32x4*)(Hb + (size_t)rw * DM + col); fw[h][c] = *(const u32x4*)(F + (size_t)rw * DM + col); } }
#pragma unroll
        for (int h = 0; h < 2; ++h) { const int rw = row + h * stride; if (rw >= nrows) break;
            const float s = wave_sum(sp[h]);
            const float rf = 1.0f / sqrtf(s * (1.0f / DM) + RMS_EPS);
            float ss = 0.f;
#pragma unroll
            for (int c = 0; c < 2; ++c) { const int col = c * 512 + lane * 8; const u32x4 hq = hw[h][c], f = fw[h][c]; f32x4 va, vb;
                va[0] = bf_lo(hq.x) + bf_lo(f.x) * rf * gv[c][0][0]; va[1] = bf_hi(hq.x) + bf_hi(f.x) * rf * gv[c][0][1]; va[2] = bf_lo(hq.y) + bf_lo(f.y) * rf * gv[c][0][2]; va[3] = bf_hi(hq.y) + bf_hi(f.y) * rf * gv[c][0][3];
                vb[0] = bf_lo(hq.z) + bf_lo(f.z) * rf * gv[c][1][0]; vb[1] = bf_hi(hq.z) + bf_hi(f.z) * rf * gv[c][1][1]; vb[2] = bf_lo(hq.w) + bf_lo(f.w) * rf * gv[c][1][2]; vb[3] = bf_hi(hq.w) + bf_hi(f.w) * rf * gv[c][1][3];
                if (last) { float* op = p.out + (size_t)rw * DM + col; *(f32x4*)op = va; *(f32x4*)(op + 4) = vb; }
                else { u32x4 w; w.x = cvt_pk_bf16(va[0], va[1]); w.y = cvt_pk_bf16(va[2], va[3]); w.z = cvt_pk_bf16(vb[0], vb[1]); w.w = cvt_pk_bf16(vb[2], vb[3]);
                    *(u32x4*)(Hb + (size_t)rw * DM + col) = w;
#pragma unroll
                    for (int e = 0; e < 4; ++e) { const float q0 = bf_lo(w[e]), q1 = bf_hi(w[e]); ss += q0 * q0 + q1 * q1; } } }
            if (!last) { ss = wave_sum(ss); if (lane == 0) rstd[rw] = 1.0f / sqrtf(ss * (1.0f / DM) + RMS_EPS); } }
    }
}
template <int W>
__device__ __forceinline__ void pool_task(const bf16_t* __restrict__ Hb, const float* __restrict__ rstd, bf16_t* __restrict__ P, int row0, int c0) {
    u32x2 raw[W + 15]; float rs[W + 15];
#pragma unroll
    for (int i = 0; i < W + 15; ++i) {
        const int off = i - (W - 1);
        int r = (off >= 0) ? row0 + off : prev_row(row0, -off);
        const bool valid = r >= 0; r = valid ? r : row0;
        raw[i] = *(const u32x2*)(Hb + (size_t)r * DM + c0); rs[i] = valid ? rstd[r] : 0.f;
    }
    const bool meta = row0 >= MREAL;
    float S[4] = {0.f, 0.f, 0.f, 0.f};
#pragma unroll
    for (int i = 0; i < W - 1; ++i) { S[0] += bf_lo(raw[i].x) * rs[i]; S[1] += bf_hi(raw[i].x) * rs[i]; S[2] += bf_lo(raw[i].y) * rs[i]; S[3] += bf_hi(raw[i].y) * rs[i]; }
#pragma unroll
    for (int o = 0; o < 16; ++o) {
        const int i = o + W - 1;
        const float u0 = bf_lo(raw[i].x) * rs[i], u1 = bf_hi(raw[i].x) * rs[i], u2 = bf_lo(raw[i].y) * rs[i], u3 = bf_hi(raw[i].y) * rs[i];
        S[0] += u0; S[1] += u1; S[2] += u2; S[3] += u3;
        const float inv = meta ? 1.0f / (float)((o + 1) < W ? (o + 1) : W) : 1.0f / (float)W;
        u32x2 w; w.x = cvt_pk_bf16(S[0] * inv - u0, S[1] * inv - u1); w.y = cvt_pk_bf16(S[2] * inv - u2, S[3] * inv - u3);
        *(u32x2*)(P + (size_t)(row0 + o) * DM + c0) = w;
        S[0] -= bf_lo(raw[o].x) * rs[o]; S[1] -= bf_hi(raw[o].x) * rs[o]; S[2] -= bf_lo(raw[o].y) * rs[o]; S[3] -= bf_hi(raw[o].y) * rs[o];
    }
}
__device__ void phase_epool(const Ctx cx, const Params& p) {
    const bf16_t* Hb = (const bf16_t*)(p.ws + WS_HB); const float* rstd = (const float*)(p.ws + WS_RSTD); bf16_t* P = (bf16_t*)(p.ws + WS_ACT);
    const int wid = __builtin_amdgcn_readfirstlane(cx.tid >> 6), lane = cx.tid & 63;
    constexpr int NTASK = (MREAL / 16 + 1) * 4;
    for (int task = cx.bid * 8 + wid; task < NTASK; task += cx.nblk * 8) {
        const int chunk = task >> 2, gI = task & 3, row0 = chunk * 16, c0 = gI * 256 + lane * 4;
        if (gI == 0) pool_task<2>(Hb, rstd, P, row0, c0); else if (gI == 1) pool_task<4>(Hb, rstd, P, row0, c0); else if (gI == 2) pool_task<8>(Hb, rstd, P, row0, c0); else pool_task<16>(Hb, rstd, P, row0, c0);
    }
}
template <int W>
__device__ __forceinline__ void pool_task_lds(const bf16_t* __restrict__ Hb, const float* __restrict__ rstd, LAS unsigned char* ldsA, int row0, int lrow0, int c0) {
    u32x2 raw[W + 15]; float rs[W + 15];
#pragma unroll
    for (int i = 0; i < W + 15; ++i) {
        const int off = i - (W - 1);
        int r = (off >= 0) ? row0 + off : prev_row(row0, -off);
        const bool valid = r >= 0; r = valid ? r : row0;
        raw[i] = *(const u32x2*)(Hb + (size_t)r * DM + c0); rs[i] = valid ? rstd[r] : 0.f;
    }
    const bool meta = row0 >= MREAL;
    float S[4] = {0.f, 0.f, 0.f, 0.f};
#pragma unroll
    for (int i = 0; i < W - 1; ++i) { S[0] += bf_lo(raw[i].x) * rs[i]; S[1] += bf_hi(raw[i].x) * rs[i]; S[2] += bf_lo(raw[i].y) * rs[i]; S[3] += bf_hi(raw[i].y) * rs[i]; }
#pragma unroll
    for (int o = 0; o < 16; ++o) {
        const int i = o + W - 1;
        const float u0 = bf_lo(raw[i].x) * rs[i], u1 = bf_hi(raw[i].x) * rs[i], u2 = bf_lo(raw[i].y) * rs[i], u3 = bf_hi(raw[i].y) * rs[i];
        S[0] += u0; S[1] += u1; S[2] += u2; S[3] += u3;
        const float inv = meta ? 1.0f / (float)((o + 1) < W ? (o + 1) : W) : 1.0f / (float)W;
        u32x2 w; w.x = cvt_pk_bf16(S[0] * inv - u0, S[1] * inv - u1); w.y = cvt_pk_bf16(S[2] * inv - u2, S[3] * inv - u3);
        *(LAS u32x2*)(ldsA + (lrow0 + o) * PA_STRIDE_B + c0 * 2) = w;
        S[0] -= bf_lo(raw[o].x) * rs[o]; S[1] -= bf_hi(raw[o].x) * rs[o]; S[2] -= bf_lo(raw[o].y) * rs[o]; S[3] -= bf_hi(raw[o].y) * rs[o];
    }
}
__device__ void phase_poolmix(const Ctx cx, LAS unsigned char* lds, const bf16_t* Hin, const float* rstd_in, bf16_t* Hout, float* rstd_out,
                              const bf16_t* Wp  , const float* scale, const float* g1) {
    const int tid = cx.tid, w = __builtin_amdgcn_readfirstlane(tid >> 6), lane = tid & 63, fr = lane & 15, fq = lane >> 4;
    LAS float* red1 = (LAS float*)(lds + PM_RED_OFF); LAS float* red2 = red1 + 64 * 8;
    constexpr int NU = MREAL / 64 + 1;
    for (int unit = cx.bid; unit < NU; unit += cx.nblk) {
        const int row0 = unit * 64; const int nm = (unit == NU - 1) ? 1 : 4;
        for (int task = w; task < 4 * nm; task += 8) {
            const int chunk = task >> 2, gI = task & 3, c0 = gI * 256 + lane * 4, r0 = row0 + chunk * 16, l0 = chunk * 16;
            if (gI == 0) pool_task_lds<2>(Hin, rstd_in, lds, r0, l0, c0); else if (gI == 1) pool_task_lds<4>(Hin, rstd_in, lds, r0, l0, c0);
            else if (gI == 2) pool_task_lds<8>(Hin, rstd_in, lds, r0, l0, c0); else pool_task_lds<16>(Hin, rstd_in, lds, r0, l0, c0);
        }
        __syncthreads();
        f32x4 acc[4][8];
#pragma unroll
        for (int m = 0; m < 4; ++m)
#pragma unroll
            for (int nb = 0; nb < 8; ++nb) acc[m][nb] = (f32x4){0.f, 0.f, 0.f, 0.f};
        const int kA = (w >> 1) * 256 + fq * 8;
        unsigned long long bbi = (unsigned long long)(Wp + ((size_t)w * 64 * 64 + lane) * 8); asm volatile("" : "+v"(bbi));
        const __attribute__((address_space(1))) bf16x8* bb = (const __attribute__((address_space(1))) bf16x8*)bbi;
#define PMX_B(nb, ks) (bb[((nb) * 8 + (ks)) * 64])
        bf16x8 bc[8], bn[8];
#pragma unroll
        for (int nb = 0; nb < 8; ++nb) bc[nb] = PMX_B(nb, 0);
#pragma unroll
        for (int ks = 0; ks < 8; ++ks) {
            if (ks < 7) {
#pragma unroll
                for (int nb = 0; nb < 8; ++nb) bn[nb] = PMX_B(nb, ks + 1);
            }
#pragma unroll
            for (int m = 0; m < 4; ++m) if (m < nm) {
                const bf16x8 a = *(const LAS bf16x8*)(lds + (m * 16 + fr) * PA_STRIDE_B + (kA + ks * 32) * 2);
#pragma unroll
                for (int nb = 0; nb < 8; ++nb) acc[m][nb] = __builtin_amdgcn_mfma_f32_16x16x32_bf16(bc[nb], a, acc[m][nb], 0, 0, 0);
            }
#pragma unroll
            for (int nb = 0; nb < 8; ++nb) bc[nb] = bn[nb];
        }
#undef PMX_B
#pragma unroll
        for (int cg = 0; cg < 4; ++cg) {
            const int c8 = 128 * w + 32 * cg + 8 * fq;
            const f32x4 s0 = *(const f32x4*)(scale + c8), s1 = *(const f32x4*)(scale + c8 + 4);
#pragma unroll
            for (int m = 0; m < 4; ++m) { acc[m][2 * cg] *= s0; acc[m][2 * cg + 1] *= s1; }
        }
#pragma unroll
        for (int m = 0; m < 4; ++m) {
            float ssq = 0.f;
#pragma unroll
            for (int nb = 0; nb < 8; ++nb) { const f32x4 v = acc[m][nb]; ssq += (v[0] * v[0] + v[1] * v[1]) + (v[2] * v[2] + v[3] * v[3]); }
            ssq += __shfl_xor(ssq, 16); ssq += __shfl_xor(ssq, 32);
            if (fq == 0) red1[(m * 16 + fr) * 8 + w] = ssq;
        }
        __syncthreads();
        float rf[4];
#pragma unroll
        for (int m = 0; m < 4; ++m) { const f32x4 x0 = *(LAS f32x4*)(red1 + (m * 16 + fr) * 8), x1 = *(LAS f32x4*)(red1 + (m * 16 + fr) * 8 + 4);
            rf[m] = 1.0f / sqrtf(((x0[0] + x0[1]) + (x0[2] + x0[3]) + (x1[0] + x1[1]) + (x1[2] + x1[3])) * (1.0f / DM) + RMS_EPS); }
        float s2[4] = {0.f, 0.f, 0.f, 0.f};
#pragma unroll
        for (int cg = 0; cg < 4; ++cg) {
            const int c8 = 128 * w + 32 * cg + 8 * fq;
            const f32x4 g0 = *(const f32x4*)(g1 + c8), g4 = *(const f32x4*)(g1 + c8 + 4);
#pragma unroll
            for (int m = 0; m < 4; ++m) if (m < nm) {
                const size_t off = (size_t)(row0 + m * 16 + fr) * DM + c8;
                const u32x4 ho = *(const u32x4*)(Hin + off);
                const f32x4 va = acc[m][2 * cg] * rf[m] * g0, vb = acc[m][2 * cg + 1] * rf[m] * g4;
                u32x4 o;
                o.x = cvt_pk_bf16(bf_lo(ho.x) + va[0], bf_hi(ho.x) + va[1]); o.y = cvt_pk_bf16(bf_lo(ho.y) + va[2], bf_hi(ho.y) + va[3]);
                o.z = cvt_pk_bf16(bf_lo(ho.z) + vb[0], bf_hi(ho.z) + vb[1]); o.w = cvt_pk_bf16(bf_lo(ho.w) + vb[2], bf_hi(ho.w) + vb[3]);
                *(u32x4*)(Hout + off) = o;
#pragma unroll
                for (int e = 0; e < 4; ++e) { const float q0 = bf_lo(o[e]), q1 = bf_hi(o[e]); s2[m] += q0 * q0 + q1 * q1; }
            }
        }
#pragma unroll
        for (int m = 0; m < 4; ++m) { float t = s2[m]; t += __shfl_xor(t, 16); t += __shfl_xor(t, 32); if (fq == 0) red2[(m * 16 + fr) * 8 + w] = t; }
        lds_barrier();
        if (tid < 16 * nm) { const f32x4 x0 = *(LAS f32x4*)(red2 + tid * 8), x1 = *(LAS f32x4*)(red2 + tid * 8 + 4);
            rstd_out[row0 + tid] = 1.0f / sqrtf(((x0[0] + x0[1]) + (x0[2] + x0[3]) + (x1[0] + x1[1]) + (x1[2] + x1[3])) * (1.0f / DM) + RMS_EPS); }
        lds_barrier();
    }
}
__device__ void phase_econv(const Ctx cx, const Params& p, const float* cw) {
    const bf16_t* CV = (const bf16_t*)(p.ws + WS_ACT); const bf16_t* Bb = CV + (size_t)MROWS * DM; bf16_t* Y = (bf16_t*)(p.ws + WS_ACT) + (size_t)2 * MROWS * DM;
    const int tid = cx.tid, sub = tid >> 7, c0 = (tid & 127) * 8;
    float w0[8], w1[8], w2[8];
#pragma unroll
    for (int e = 0; e < 8; ++e) { w0[e] = cw[c0 + e]; w1[e] = cw[DM + c0 + e]; w2[e] = cw[2 * DM + c0 + e]; }
    constexpr int NCH = (MREAL + 16) / 4;
    for (int ch = cx.bid * 4 + sub; ch < NCH; ch += cx.nblk * 4) {
        const int row0 = ch * 4; const int r1 = prev_row(row0, 1), r2 = prev_row(row0, 2);
        const u32x4 z = (u32x4){0u, 0u, 0u, 0u};
        u32x4 x[6], bb[4];
        x[0] = r2 >= 0 ? *(const u32x4*)(CV + (size_t)r2 * DM + c0) : z;
        x[1] = r1 >= 0 ? *(const u32x4*)(CV + (size_t)r1 * DM + c0) : z;
#pragma unroll
        for (int i = 0; i < 4; ++i) { x[2 + i] = *(const u32x4*)(CV + (size_t)(row0 + i) * DM + c0); bb[i] = *(const u32x4*)(Bb + (size_t)(row0 + i) * DM + c0); }
#pragma unroll
        for (int i = 0; i < 4; ++i) {
            float y[8];
#pragma unroll
            for (int e = 0; e < 4; ++e) {
                y[2 * e] = bf_lo(bb[i][e]) * (w0[2 * e] * bf_lo(x[i][e]) + w1[2 * e] * bf_lo(x[i + 1][e]) + w2[2 * e] * bf_lo(x[i + 2][e]));
                y[2 * e + 1] = bf_hi(bb[i][e]) * (w0[2 * e + 1] * bf_hi(x[i][e]) + w1[2 * e + 1] * bf_hi(x[i + 1][e]) + w2[2 * e + 1] * bf_hi(x[i + 2][e]));
            }
            u32x4 o; o.x = cvt_pk_bf16(y[0], y[1]); o.y = cvt_pk_bf16(y[2], y[3]); o.z = cvt_pk_bf16(y[4], y[5]); o.w = cvt_pk_bf16(y[6], y[7]);
            *(u32x4*)(Y + (size_t)(row0 + i) * DM + c0) = o;
        }
    }
}
__device__ void fixup_rows(const Ctx cx, const Params& p, const StaticOrder& S, const float* cw) {
    bf16_t* A = (bf16_t*)(p.ws + WS_ACT); const float* hg = (const float*)(p.ws + WS_HG); const float* hr = (const float*)(p.ws + WS_HR);
    int nun = 0; { Unit u; while (S.next(nun, u)) ++nun; }
    constexpr int NQ = FF / 4;
    for (int t = cx.tid; t < nun * NQ; t += 512) {
        Unit u; S.next(t / NQ, u);
        const int pm = u.pm, j = (t % NQ) * 4;
        const float* src = ((pm & 7) == 0) ? hg + (size_t)META_TILE * 2 * FF : hg + (size_t)(pm - 1) * 2 * FF;
        const f32x4 gm2 = *(const f32x4*)(src + j), gm1 = *(const f32x4*)(src + FF + j);
        const float* h0 = hr + ((size_t)pm * 2 + 0) * 2 * FF + j; const float* h1 = hr + ((size_t)pm * 2 + 1) * 2 * FF + j;
        const f32x4 g0 = *(const f32x4*)h0, v0 = *(const f32x4*)(h0 + FF), g1 = *(const f32x4*)h1, v1 = *(const f32x4*)(h1 + FF);
        const f32x4 k0 = *(const f32x4*)(cw + j), k1 = *(const f32x4*)(cw + FF + j), k2 = *(const f32x4*)(cw + 2 * FF + j);
        const f32x4 c0 = k0 * gm2 + k1 * gm1 + k2 * g0, c1 = k0 * gm1 + k1 * g0 + k2 * g1;
        u32x2 o0, o1;
        o0.x = cvt_pk_bf16(silu_mul(c0[0], v0[0]), silu_mul(c0[1], v0[1])); o0.y = cvt_pk_bf16(silu_mul(c0[2], v0[2]), silu_mul(c0[3], v0[3]));
        o1.x = cvt_pk_bf16(silu_mul(c1[0], v1[0]), silu_mul(c1[1], v1[1])); o1.y = cvt_pk_bf16(silu_mul(c1[2], v1[2]), silu_mul(c1[3], v1[3]));
        *(u32x2*)(A + (size_t)(pm * BM) * FF + j) = o0; *(u32x2*)(A + (size_t)(pm * BM + 1) * FF + j) = o1;
    }
    asm volatile("s_waitcnt vmcnt(0)" ::: "memory");
    __syncthreads();
}

enum { K_PRO = 0, K_POOLMIX, K_GPOOL_UNUSED, K_ERES0, K_GUP, K_GDOWN, K_ERES1, K_GIN, K_ECONV, K_GOUT };
constexpr int N_PHASES = 23;
__device__ __forceinline__ void decode_phase(int ph, int& layer, int& kind) {
    if (ph == 0) { layer = 0; kind = K_PRO; return; }
    const int q = ph - 1, pair = q / 11, r = q % 11;
    if (r < 4) { layer = 2 * pair; kind = (r == 0) ? K_POOLMIX : (r == 1) ? K_GUP : (r == 2) ? K_GDOWN : K_ERES1; }
    else { const int s = r - 4; layer = 2 * pair + 1; kind = (s == 0) ? K_GIN : (s == 1) ? K_ECONV : (s == 2) ? K_GOUT : (s == 3) ? K_ERES0 : (s == 4) ? K_GUP : (s == 5) ? K_GDOWN : K_ERES1; }
}

__global__ void __launch_bounds__(512, 2) mk_fwd(Params p_in) {
    extern __shared__ __attribute__((aligned(16))) unsigned char shm[];
    LAS unsigned char* lds = (LAS unsigned char*)shm;
    cg::grid_group grid = cg::this_grid();
    typedef const Params __attribute__((address_space(4)))* KArgPtr;
    const int ph_hi = p_in.ph_hi, coop = p_in.coop;
    XcdBarrier xb; xb.bar = (unsigned*)(p_in.ws + WS_BAR); xb.x = 0; xb.st = (volatile LAS unsigned*)(lds + XBST_OFF);
    if (coop) {
        if (threadIdx.x == 0) { xb.st[0] = 0u; xb.st[1] = 0u; }
        __syncthreads();
        xb.x = xb_xcc_id();
        if (threadIdx.x == 0) (void)xb_add(&xb.bar[XB_XCNT(xb.x)], 1u);
    }
#ifndef PROBE_REPEAT_MASK
#define PROBE_REPEAT_MASK 0
#endif
    for (int ph2 = p_in.ph_lo * 2; ph2 < ph_hi * 2; ++ph2) {
        const int ph = ph2 >> 1;
        int layer, kind; decode_phase(ph, layer, kind);
        if ((ph2 & 1) && !((PROBE_REPEAT_MASK >> kind) & 1)) continue;
        KArgPtr kp = (KArgPtr)__builtin_amdgcn_kernarg_segment_ptr();
        asm volatile("" : "+s"(layer), "+s"(kind), "+s"(kp));
        Params p;
        p.x = kp->x; p.meta = kp->meta; p.pool_w = kp->pool_w; p.pool_scale = kp->pool_scale; p.sc_w_in = kp->sc_w_in; p.sc_conv = kp->sc_conv; p.sc_w_out = kp->sc_w_out;
        p.ffn_w_up = kp->ffn_w_up; p.ffn_conv = kp->ffn_conv; p.ffn_w_down = kp->ffn_w_down; p.norm_g = kp->norm_g; p.out = kp->out; p.ws = kp->ws;
        p.ph_lo = 0; p.ph_hi = 0; p.coop = 0; p.pad = 0;
        unsigned char* wsb = p.ws;
        Ctx cx; cx.tid = threadIdx.x; cx.bid = blockIdx.x; cx.nblk = gridDim.x;
        asm volatile("" : "+v"(cx.tid), "+s"(cx.bid), "+s"(cx.nblk));
#ifdef ONLY_KIND
        kind = ONLY_KIND;
#endif
        const int sidx = layer * 2 + ((kind == K_GUP || kind == K_GDOWN || kind == K_ERES1) ? 1 : 0);
        const bool useB = (sidx >= 1 && sidx <= 4);
        bf16_t* Hb = (bf16_t*)(wsb + (useB ? WS_HB2 : WS_HB)); float* rstd = (float*)(wsb + (useB ? WS_RSTD2 : WS_RSTD));
        bf16_t* F = (bf16_t*)(wsb + WS_F); bf16_t* ACT = (bf16_t*)(wsb + WS_ACT);
        float* ssp = (float*)(wsb + WS_SSF); const float* ones = (const float*)(wsb + WS_ONES);
        const int j = layer >> 1;
        StaticOrder S;
        switch (kind) {
        case K_PRO: phase_prologue(cx, p, lds); break;
        case K_POOLMIX: {
            bf16_t* Ho = (bf16_t*)(wsb + (useB ? WS_HB : WS_HB2)); float* ro = (float*)(wsb + (useB ? WS_RSTD : WS_RSTD2));
            phase_poolmix(cx, lds, Hb, rstd, Ho, ro, (const bf16_t*)(wsb + WS_WP) + (size_t)j * 1024 * 256, p.pool_scale + (size_t)j * DM, p.norm_g + (layer * 4 + 1) * DM);
        } break;
        case K_ECONV: phase_econv(cx, p, p.sc_conv + (size_t)j * 3 * DM); break;
        case K_ERES0: phase_eres(cx, p, Hb, rstd, p.norm_g + (layer * 4 + 1) * DM, false); break;
        case K_ERES1: phase_eres(cx, p, Hb, rstd, p.norm_g + (layer * 4 + 3) * DM, layer == 3); break;
        case K_GDOWN: case K_GOUT: {
            Gemm g; EpiF E; E.F = F; E.ssp = ssp; E.scale = ones; SkF SE; SE.F = F; SE.ssm = (float*)(wsb + WS_SSM); SE.scale = ones; SE.pool = 0;
            if (kind == K_GDOWN) g = Gemm{ACT, (const bf16_t*)(wsb + WS_WDN) + (size_t)layer * DM * FF, MREAL, DM, FF, FF, FF, 0};
            else g = Gemm{ACT + (size_t)2 * MROWS * DM, (const bf16_t*)(wsb + WS_WOUT) + (size_t)j * DM * DM, MREAL, DM, DM, DM, DM, 0};
            S.init(g.M, g.N, cx.nblk, cx.bid);
            if (kind == K_GDOWN) fixup_rows(cx, p, S, p.ffn_conv + (size_t)layer * 3 * FF);
            gemm_phase<EpiF>(cx, lds, g, S, E);
            const bf16_t* A16 = g.A + (size_t)MREAL * g.lda;
            if (kind == K_GDOWN) skinny_gemm<11, SkF>(cx, lds, A16, g.lda, g.Bt, g.ldb, 32, SE);
            else skinny_gemm<4, SkF>(cx, lds, A16, g.lda, g.Bt, g.ldb, 32, SE);
        } break;
        case K_GUP: {
            Gemm g{Hb, (const bf16_t*)(wsb + WS_WUP) + (size_t)layer * 5632 * DM, MREAL, 5632, DM, DM, DM, 0};
            EpiUp E{ACT, rstd, p.ffn_conv + (size_t)layer * 3 * FF, (float*)(wsb + WS_HG), (float*)(wsb + WS_HR)};
            S.init(g.M, g.N, cx.nblk, cx.bid);
            gemm_phase<EpiUp>(cx, lds, g, S, E);
            SkUp SE{ACT, rstd, p.ffn_conv + (size_t)layer * 3 * FF, (float*)(wsb + WS_HG)};
            skinny_gemm<4, SkUp>(cx, lds, Hb + (size_t)MREAL * DM, DM, g.Bt, DM, 176, SE);
        } break;
        case K_GIN: {
            Gemm g{Hb, (const bf16_t*)(wsb + WS_WIN) + (size_t)j * 3072 * DM, MREAL, 3072, DM, DM, DM, 0};
            EpiIn E{ACT, ACT + (size_t)MROWS * DM, rstd};
            S.init(g.M, g.N, cx.nblk, cx.bid);
            gemm_phase<EpiIn>(cx, lds, g, S, E);
            SkIn SE{ACT, ACT + (size_t)MROWS * DM, rstd};
            skinny_gemm<4, SkIn>(cx, lds, Hb + (size_t)MREAL * DM, DM, g.Bt, DM, 96, SE);
        } break;
        }
        if (ph2 + 1 < ph_hi * 2 && (!(ph2 & 1) ? (((PROBE_REPEAT_MASK >> kind) & 1) || ph + 1 < ph_hi) : (ph + 1 < ph_hi))) { if (coop == 2) grid.sync(); else if (coop) xcd_barrier(xb, cx.tid, (unsigned)cx.nblk); }
    }
}

extern "C" void kernel_launch(void* const* d_in, const int* in_sizes, int n_in, void* d_out, int out_size, void* d_ws, size_t ws_size, hipStream_t stream) {
    static int grid = 0;
    if (grid == 0) {
        if (n_in != 11 || out_size != MREAL * DM || ws_size < WS_END) { fprintf(stderr, "kernel_launch: unexpected shapes (n_in %d out %d ws %zu need %zu)\n", n_in, out_size, ws_size, (size_t)WS_END); grid = -1; return; }
        int dev = 0, cus = 0, per_cu = 0;
        hipGetDevice(&dev); hipDeviceGetAttribute(&cus, hipDeviceAttributeMultiprocessorCount, dev);
        if (hipFuncSetAttribute((const void*)mk_fwd, hipFuncAttributeMaxDynamicSharedMemorySize, LDS_BYTES) != hipSuccess) { fprintf(stderr, "kernel_launch: hipFuncSetAttribute failed\n"); grid = -1; return; }
        if (hipOccupancyMaxActiveBlocksPerMultiprocessor(&per_cu, (const void*)mk_fwd, 512, LDS_BYTES) != hipSuccess || per_cu < 1) { fprintf(stderr, "kernel_launch: occupancy query says %d\n", per_cu); per_cu = 1; }
        (void)hipGetLastError();
        grid = cus * 1;
    }
    if (grid < 0) return;
    Params p{};
    p.x = (const float*)d_in[0]; p.meta = (const float*)d_in[1]; p.pool_w = (const float*)d_in[2]; p.pool_scale = (const float*)d_in[3]; p.sc_w_in = (const float*)d_in[4];
    p.sc_conv = (const float*)d_in[5]; p.sc_w_out = (const float*)d_in[6]; p.ffn_w_up = (const float*)d_in[7]; p.ffn_conv = (const float*)d_in[8]; p.ffn_w_down = (const float*)d_in[9];
    p.norm_g = (const float*)d_in[10]; p.out = (float*)d_out; p.ws = (unsigned char*)d_ws;
#if MK_ONE_LAUNCH
    p.ph_lo = 0; p.ph_hi = N_PHASES; p.coop = 1;
    void* args[] = {&p};
    if (hipMemsetAsync((unsigned char*)d_ws + WS_BAR, 0, 16384, stream) != hipSuccess) { fprintf(stderr, "kernel_launch: memset of the barrier words failed\n"); return; }
    hipError_t e = hipLaunchCooperativeKernel((const void*)mk_fwd, dim3(grid), dim3(512), args, LDS_BYTES, stream);
    if (e != hipSuccess) fprintf(stderr, "kernel_launch: cooperative launch failed: %s (grid %d)\n", hipGetErrorString(e), grid);
#else
    for (int ph = 0; ph < N_PHASES; ++ph) {
        p.ph_lo = ph; p.ph_hi = ph + 1; p.coop = 0;
        hipLaunchKernelGGL(mk_fwd, dim3(grid), dim3(512), LDS_BYTES, stream, p);
    }
#endif
}
```
